# Optimizing an MI355X kernel written in HIP

```python
import math
import jax, jax.numpy as jnp
from jax import lax
import numpy as np

D_MODEL = 1024
BATCH = 8
SEQ = 4096
DEPTH = 2

N_MIXERS = 2
N_ATTN_LAYERS = (DEPTH + 1) // 2
N_CONV_LAYERS = DEPTH // 2
RMS_EPS = 1e-6

HEAD_DIM = 64
N_Q_HEADS = D_MODEL // HEAD_DIM
N_KV_HEADS = 4
GROUP = N_Q_HEADS // N_KV_HEADS
WINDOW = 128
ROT_DIM = HEAD_DIM // 4
ROPE_THETA = 500000.0
QKV_DIM = (N_Q_HEADS + 2 * N_KV_HEADS) * HEAD_DIM
NEG_INF = -1e30

CONV_WIDTH = 3

PEER_HEADS = 8
N_KEYS = 128
N_EXPERTS = N_KEYS * N_KEYS
PEER_TOPK = 16
QUERY_DIM = 256
QUERY_HALF = QUERY_DIM // 2
TOKEN_BLOCK = 128

kernel_name = "hybrid_swa_sink_shortconv_peer"


def rmsnorm(x, gain):
    x32 = x.astype(jnp.float32)
    y = x32 * lax.rsqrt(jnp.mean(x32 * x32, axis=-1, keepdims=True) + RMS_EPS)
    return (y * gain.astype(jnp.float32)).astype(x.dtype)


def partial_rope(x, pos):
    half = ROT_DIM // 2
    freqs = ROPE_THETA ** (-jnp.arange(0, ROT_DIM, 2, dtype=jnp.float32) / ROT_DIM)
    ang = pos.astype(jnp.float32)[:, None] * freqs[None, :]
    cos = jnp.cos(ang)[None, :, None, :]
    sin = jnp.sin(ang)[None, :, None, :]
    x32 = x.astype(jnp.float32)
    x1, x2, rest = x32[..., :half], x32[..., half:ROT_DIM], x32[..., ROT_DIM:]
    out = jnp.concatenate([x1 * cos - x2 * sin, x2 * cos + x1 * sin, rest], axis=-1)
    return out.astype(x.dtype)


def sliding_window_attention(xn, w_qkv, q_gain, k_gain, sinks, w_o):
    B, S, _ = xn.shape
    nb = S // WINDOW
    qkv = xn @ w_qkv
    q_end = N_Q_HEADS * HEAD_DIM
    k_end = q_end + N_KV_HEADS * HEAD_DIM
    q = qkv[..., :q_end].reshape(B, S, N_Q_HEADS, HEAD_DIM)
    k = qkv[..., q_end:k_end].reshape(B, S, N_KV_HEADS, HEAD_DIM)
    v = qkv[..., k_end:].reshape(B, S, N_KV_HEADS, HEAD_DIM)
    q = rmsnorm(q, q_gain)
    k = rmsnorm(k, k_gain)
    pos = jnp.arange(S)
    q = partial_rope(q, pos)
    k = partial_rope(k, pos)

    qb = q.reshape(B, nb, WINDOW, N_KV_HEADS, GROUP, HEAD_DIM)
    pad = ((0, 0), (WINDOW, 0), (0, 0), (0, 0))
    kp = jnp.pad(k, pad).reshape(B, nb + 1, WINDOW, N_KV_HEADS, HEAD_DIM)
    vp = jnp.pad(v, pad).reshape(B, nb + 1, WINDOW, N_KV_HEADS, HEAD_DIM)
    kband = jnp.concatenate([kp[:, :-1], kp[:, 1:]], axis=2)
    vband = jnp.concatenate([vp[:, :-1], vp[:, 1:]], axis=2)

    scale = 1.0 / math.sqrt(HEAD_DIM)
    s = jnp.einsum('bnqhgd,bnkhd->bnhgqk', qb, kband).astype(jnp.float32) * scale
    qi = jnp.arange(WINDOW)[:, None]
    ki = jnp.arange(2 * WINDOW)[None, :]
    rel = WINDOW + qi - ki
    band = (rel >= 0) & (rel < WINDOW)
    blk = jnp.arange(nb)[:, None, None]
    valid = band[None] & (blk * WINDOW + ki[None] >= WINDOW)
    s = jnp.where(valid[None, :, None, None], s, NEG_INF)

    sink = sinks.astype(jnp.float32).reshape(N_KV_HEADS, GROUP)[None, None, :, :, None, None]
    sink = jnp.broadcast_to(sink, s.shape[:-1] + (1,))
    p = jax.nn.softmax(jnp.concatenate([s, sink], axis=-1), axis=-1)[..., :-1]
    o = jnp.einsum('bnhgqk,bnkhd->bnqhgd', p.astype(vband.dtype), vband)
    return o.reshape(B, S, N_Q_HEADS * HEAD_DIM) @ w_o


def short_gated_conv(xn, w_in, conv_w, w_out):
    B, S, D = xn.shape
    bcu = xn @ w_in
    gate_b = bcu[..., :D]
    gate_c = bcu[..., D:2 * D]
    u = bcu[..., 2 * D:]
    z = gate_c * u
    zp = jnp.pad(z, ((0, 0), (CONV_WIDTH - 1, 0), (0, 0)))
    conv = sum(conv_w[j] * zp[:, j:j + S] for j in range(CONV_WIDTH))
    return (gate_b * conv) @ w_out


def peer_ffn(xn, w_query, sub_keys, expert_u, expert_v):
    B, S, D = xn.shape
    T = B * S
    xt = xn.reshape(T, D)
    q = (xt @ w_query).reshape(T, PEER_HEADS, 2, QUERY_HALF)
    s = jnp.einsum('thpd,hpnd->thpn', q, sub_keys).astype(jnp.float32)
    s_top, i_top = lax.top_k(s, PEER_TOPK)
    cand = (s_top[:, :, 0, :, None] + s_top[:, :, 1, None, :]).reshape(T, PEER_HEADS, PEER_TOPK * PEER_TOPK)
    cand_idx = (i_top[:, :, 0, :, None] * N_KEYS + i_top[:, :, 1, None, :]).reshape(T, PEER_HEADS, PEER_TOPK * PEER_TOPK)
    g_s, sel = lax.top_k(cand, PEER_TOPK)
    idx = jnp.take_along_axis(cand_idx, sel, axis=-1)
    g = jax.nn.softmax(g_s, axis=-1)

    nblk = T // TOKEN_BLOCK

    def expert_block(args):
        xc, ic, gc = args
        u = jnp.take(expert_u, ic, axis=0)
        a = jnp.einsum('td,thkd->thk', xc, u).astype(jnp.float32)
        w = (gc * jax.nn.gelu(a, approximate=False)).astype(xc.dtype)
        v = jnp.take(expert_v, ic, axis=0)
        return jnp.einsum('thk,thkd->td', w, v)

    y = lax.map(expert_block, (xt.reshape(nblk, TOKEN_BLOCK, D),
                               idx.reshape(nblk, TOKEN_BLOCK, PEER_HEADS, PEER_TOPK),
                               g.reshape(nblk, TOKEN_BLOCK, PEER_HEADS, PEER_TOPK)))
    return y.reshape(B, S, D)


def setup_inputs(seed: int = 0) -> dict:
    key = jax.random.key(seed)
    ks = jax.random.split(key, 16)
    D = D_MODEL
    nrm = jax.random.normal
    x = nrm(ks[0], (BATCH, SEQ, D), jnp.float32)
    norm_mix = 1.0 + 0.05 * nrm(ks[1], (DEPTH, D), jnp.float32)
    norm_ffn = 1.0 + 0.05 * nrm(ks[2], (DEPTH, D), jnp.float32)
    attn_w_qkv = nrm(ks[3], (N_ATTN_LAYERS, D, QKV_DIM), jnp.float32) * D ** -0.5
    attn_q_norm = 1.0 + 0.05 * nrm(ks[4], (N_ATTN_LAYERS, HEAD_DIM), jnp.float32)
    attn_k_norm = 1.0 + 0.05 * nrm(ks[5], (N_ATTN_LAYERS, HEAD_DIM), jnp.float32)
    attn_sinks = 0.5 * nrm(ks[6], (N_ATTN_LAYERS, N_Q_HEADS), jnp.float32)
    attn_w_o = nrm(ks[7], (N_ATTN_LAYERS, N_Q_HEADS * HEAD_DIM, D), jnp.float32) * (N_Q_HEADS * HEAD_DIM) ** -0.5
    conv_w_in = nrm(ks[8], (N_CONV_LAYERS, D, 3 * D), jnp.float32) * D ** -0.5
    conv_w = nrm(ks[9], (N_CONV_LAYERS, CONV_WIDTH, D), jnp.float32) * CONV_WIDTH ** -0.5
    conv_w_out = nrm(ks[10], (N_CONV_LAYERS, D, D), jnp.float32) * D ** -0.5
    peer_w_query = nrm(ks[11], (DEPTH, D, PEER_HEADS * QUERY_DIM), jnp.float32) * D ** -0.5
    peer_sub_keys = nrm(ks[12], (DEPTH, PEER_HEADS, 2, N_KEYS, QUERY_HALF), jnp.float32) * QUERY_HALF ** -0.5
    peer_u = nrm(ks[13], (DEPTH, N_EXPERTS, D), jnp.float32) * D ** -0.5
    peer_v = nrm(ks[14], (DEPTH, N_EXPERTS, D), jnp.float32) * (PEER_HEADS * PEER_TOPK) ** -0.5
    return {"x": x, "norm_mix": norm_mix, "norm_ffn": norm_ffn,
            "attn_w_qkv": attn_w_qkv, "attn_q_norm": attn_q_norm, "attn_k_norm": attn_k_norm,
            "attn_sinks": attn_sinks, "attn_w_o": attn_w_o,
            "conv_w_in": conv_w_in, "conv_w": conv_w, "conv_w_out": conv_w_out,
            "peer_w_query": peer_w_query, "peer_sub_keys": peer_sub_keys,
            "peer_u": peer_u, "peer_v": peer_v}


def reference(x, norm_mix, norm_ffn, attn_w_qkv, attn_q_norm, attn_k_norm, attn_sinks, attn_w_o,
              conv_w_in, conv_w, conv_w_out, peer_w_query, peer_sub_keys, peer_u, peer_v):
    for i in range(DEPTH):
        h = rmsnorm(x, norm_mix[i])
        j = i // N_MIXERS
        if i % N_MIXERS == 0:
            x = x + sliding_window_attention(h, attn_w_qkv[j], attn_q_norm[j], attn_k_norm[j],
                                             attn_sinks[j], attn_w_o[j])
        else:
            x = x + short_gated_conv(h, conv_w_in[j], conv_w[j], conv_w_out[j])
        h = rmsnorm(x, norm_ffn[i])
        x = x + peer_ffn(h, peer_w_query[i], peer_sub_keys[i], peer_u[i], peer_v[i])
    return x
```

```cpp
#include <hip/hip_runtime.h>
#include <hip/hip_cooperative_groups.h>
#include <cstdio>
namespace cg = cooperative_groups;

#ifndef PROBE_GV2
#define PROBE_GV2 0
#endif
#ifndef PROBE_GU
#define PROBE_GU 0
#endif
#ifndef PROBE_GV
#define PROBE_GV 0
#endif
#ifndef MULTI_LAUNCH
#define MULTI_LAUNCH 0
#endif

typedef __attribute__((ext_vector_type(8))) short bf16x8;
typedef __attribute__((ext_vector_type(16))) float f32x16;
typedef __attribute__((ext_vector_type(4))) float f32x4;
typedef __attribute__((ext_vector_type(4))) unsigned u32x4;
typedef __attribute__((ext_vector_type(2))) unsigned u32x2;
typedef __attribute__((ext_vector_type(4))) int i32x4;
typedef __bf16 bf2_t __attribute__((ext_vector_type(2)));
typedef float f2_t __attribute__((ext_vector_type(2)));

#define DI __device__ __forceinline__
#define MFMA32(a, b, c) __builtin_amdgcn_mfma_f32_32x32x16_bf16((a), (b), (c), 0, 0, 0)

constexpr int T = 32768;
constexpr int SEQ = 4096;
constexpr float EPS = 1e-6f;

constexpr size_t OFF_WQKVT = 0;
constexpr size_t OFF_WOT   = OFF_WQKVT + (size_t)1536 * 1024 * 2;
constexpr size_t OFF_WINT  = OFF_WOT + (size_t)1024 * 1024 * 2;
constexpr size_t OFF_WOUTT = OFF_WINT + (size_t)3072 * 1024 * 2;
constexpr size_t OFF_WQT   = OFF_WOUTT + (size_t)1024 * 1024 * 2;
constexpr size_t OFF_KEYS  = OFF_WQT + (size_t)2 * 2048 * 1024 * 2;
constexpr size_t OFF_ROPE  = OFF_KEYS + (size_t)2 * 262144 * 2;
constexpr size_t OFF_SS    = OFF_ROPE + (size_t)4096 * 8 * 8;
constexpr size_t OFF_UB    = OFF_SS + (size_t)4 * T * 4;
constexpr size_t OFF_SU    = OFF_UB + (size_t)2 * 16384 * 1024;
constexpr size_t OFF_VB    = OFF_UB + (size_t)2 * 16384 * 1024 * 2;
constexpr size_t OFF_SV    = OFF_VB + (size_t)2 * 16384 * 1024;
constexpr size_t OFF_XB    = OFF_VB + (size_t)2 * 16384 * 1024 * 2;
constexpr size_t OFF_IDX   = OFF_XB + (size_t)T * 1024 * 2;
constexpr size_t OFF_G     = OFF_IDX + (size_t)T * 128 * 4;
constexpr size_t OFF_BIG   = OFF_G + (size_t)T * 128 * 4;
constexpr size_t OFF_Q     = OFF_BIG;
constexpr size_t OFF_K     = OFF_Q + (size_t)T * 1024 * 2;
constexpr size_t OFF_VT    = OFF_K + (size_t)T * 256 * 2;
constexpr size_t OFF_O     = OFF_VT + (size_t)T * 256 * 2;
constexpr size_t OFF_A     = OFF_O + (size_t)T * 1024 * 2;
constexpr size_t OFF_SUV   = OFF_A + (size_t)T * 128 * 4;
constexpr size_t OFF_X8    = OFF_SUV + (size_t)T * 128 * 4;
constexpr size_t OFF_BAR   = OFF_X8 + (size_t)T * 1024;
constexpr size_t OFF_PQ    = OFF_BIG;
constexpr size_t OFF_CB    = OFF_BIG;
constexpr size_t OFF_CZ    = OFF_CB + (size_t)T * 1024 * 2;

constexpr int NTHR = 512, NWAVE = 8;
constexpr int LDS_BYTES = 147456;
constexpr int LROW = 144;
constexpr int LSTAGE = 73728;
constexpr int LBOFF = 36864;

struct Params {
  const float* x; const float* norm_mix; const float* norm_ffn; const float* w_qkv; const float* q_norm; const float* k_norm;
  const float* sinks; const float* w_o; const float* w_in; const float* conv_w; const float* w_out; const float* w_query;
  const float* sub_keys; const float* peer_u; const float* peer_v;
  float* out; char* ws;
  int wv; int pad_;
};

DI unsigned pack2(float a, float b) { f2_t v = {a, b}; bf2_t r = __builtin_convertvector(v, bf2_t); return __builtin_bit_cast(unsigned, r); }
DI float bflo(unsigned u) { return __uint_as_float(u << 16); }
DI float bfhi(unsigned u) { return __uint_as_float(u & 0xffff0000u); }
DI int lane_id() { return (int)__builtin_amdgcn_mbcnt_hi(~0u, __builtin_amdgcn_mbcnt_lo(~0u, 0u)); }
#define TIDX (p.wv * 64 + lane_id())
DI int crow(int r, int half) { return (r & 3) + 8 * (r >> 2) + 4 * half; }

DI void transpose_job(const float* __restrict__ W, int N, short* __restrict__ Wt, const float* __restrict__ gain, bool winmap,
                      float* tlb, int bid, int nb, int tidx) {
  const int tid = tidx & 255, hb = tidx >> 8;
  float* tl = tlb + hb * (64 * 65);
  const int vbid = bid * 2 + hb, vnb = nb * 2;
  const int ntn = N >> 6;
  const int ntiles = ntn * 16;
  const int iters = (ntiles + vnb - 1) / vnb;
  for (int it = 0; it < iters; ++it) {
    const int tile = it * vnb + vbid;
    const bool act = tile < ntiles;
    const int tn = tile % ntn, tk = tile / ntn;
    const int v0 = tn << 6, k0 = tk << 6;
    __syncthreads();
    if (act) {
      const int j = tid & 63;
      int v = v0 + j, col = v;
      if (winmap && v >= 1024) {
        int w = v - 1024; int bz = w >> 7, i = w & 127; int wmm = i >> 6, mt = (i >> 5) & 1, rr = i & 31;
        col = (mt ? 2048 : 1024) + 64 * bz + 32 * wmm + rr;
      }
#pragma unroll
      for (int i = 0; i < 16; ++i) {
        int kk = (tid >> 6) + 4 * i;
        float val = W[(size_t)(k0 + kk) * N + col];
        if (gain) val *= gain[k0 + kk];
        tl[kk * 65 + j] = val;
      }
    }
    __syncthreads();
    if (act) {
#pragma unroll
      for (int c = 0; c < 2; ++c) {
        int chunk = tid + 256 * c;
        int n = chunk >> 3, kc = chunk & 7;
        u32x4 o;
        o[0] = pack2(tl[(kc * 8 + 0) * 65 + n], tl[(kc * 8 + 1) * 65 + n]);
        o[1] = pack2(tl[(kc * 8 + 2) * 65 + n], tl[(kc * 8 + 3) * 65 + n]);
        o[2] = pack2(tl[(kc * 8 + 4) * 65 + n], tl[(kc * 8 + 5) * 65 + n]);
        o[3] = pack2(tl[(kc * 8 + 6) * 65 + n], tl[(kc * 8 + 7) * 65 + n]);
        *(u32x4*)(Wt + (size_t)(v0 + n) * 1024 + k0 + kc * 8) = o;
      }
    }
  }
}

DI void convert_job(const float* __restrict__ src, short* __restrict__ dst, size_t n8, int bid, int nb, int tidx) {
  for (size_t i = (size_t)bid * NTHR + tidx; i < n8; i += (size_t)nb * NTHR) {
    f32x4 a = *(const f32x4*)(src + i * 8), b = *(const f32x4*)(src + i * 8 + 4);
    u32x4 o; o[0] = pack2(a[0], a[1]); o[1] = pack2(a[2], a[3]); o[2] = pack2(b[0], b[1]); o[3] = pack2(b[2], b[3]);
    *(u32x4*)(dst + i * 8) = o;
  }
}

typedef float f2v __attribute__((ext_vector_type(2)));
DI void fp8_job(const float* __restrict__ src, unsigned char* __restrict__ dst, float* __restrict__ scale, int nrows, const float* __restrict__ gain, int bid, int nb, int tidx) {
  const int lane = tidx & 63, gw = bid * NWAVE + (tidx >> 6), nw = nb * NWAVE;
  for (int row = gw; row < nrows; row += nw) {
    const float* rp = src + (size_t)row * 1024 + lane * 16;
    f32x4 a[4];
    float mx = 0.f;
#pragma unroll
    for (int j = 0; j < 4; ++j) { a[j] = *(const f32x4*)(rp + 4 * j); if (gain) a[j] *= *(const f32x4*)(gain + (row >> 14) * 1024 + lane * 16 + 4 * j); mx = fmaxf(mx, fmaxf(fmaxf(fabsf(a[j][0]), fabsf(a[j][1])), fmaxf(fabsf(a[j][2]), fabsf(a[j][3])))); }
#pragma unroll
    for (int m = 32; m > 0; m >>= 1) mx = fmaxf(mx, __shfl_xor(mx, m));
    mx = fmaxf(mx, 1e-30f);
    const float inv = 224.0f / mx;
    u32x4 o;
#pragma unroll
    for (int j = 0; j < 4; ++j) {
      int w = 0;
      w = __builtin_amdgcn_cvt_pk_fp8_f32(a[j][0] * inv, a[j][1] * inv, w, false);
      w = __builtin_amdgcn_cvt_pk_fp8_f32(a[j][2] * inv, a[j][3] * inv, w, true);
      o[j] = (unsigned)w;
    }
    *(u32x4*)(dst + (size_t)(row >> 14) * (16384 * 1024) + (size_t)(lane >> 3) * (16384 * 128) + (size_t)(row & 16383) * 128 + (lane & 7) * 16) = o;
    if (lane == 0) scale[row] = mx * (1.0f / 224.0f);
  }
}

DI void i8_job(const float* __restrict__ src, unsigned char* __restrict__ dst, float* __restrict__ scale, int nrows, const float* __restrict__ gain, int bid, int nb, int tidx) {
  const int lane = tidx & 63, gw = bid * NWAVE + (tidx >> 6), nw = nb * NWAVE;
  for (int row = gw; row < nrows; row += nw) {
    const float* rp = src + (size_t)row * 1024 + lane * 16;
    f32x4 a[4];
    float mx = 0.f;
#pragma unroll
    for (int j = 0; j < 4; ++j) { a[j] = *(const f32x4*)(rp + 4 * j); a[j] *= *(const f32x4*)(gain + (row >> 14) * 1024 + lane * 16 + 4 * j); mx = fmaxf(mx, fmaxf(fmaxf(fabsf(a[j][0]), fabsf(a[j][1])), fmaxf(fabsf(a[j][2]), fabsf(a[j][3])))); }
#pragma unroll
    for (int m = 32; m > 0; m >>= 1) mx = fmaxf(mx, __shfl_xor(mx, m));
    mx = fmaxf(mx, 1e-30f);
    const float inv = 127.0f / mx;
    u32x4 o;
#pragma unroll
    for (int j = 0; j < 4; ++j) {
      unsigned w = 0;
#pragma unroll
      for (int e = 0; e < 4; ++e) { int q = __float2int_rn(a[j][e] * inv); q = q > 127 ? 127 : (q < -127 ? -127 : q); w |= ((unsigned)q & 0xffu) << (8 * e); }
      o[j] = w;
    }
    *(u32x4*)(dst + (size_t)(row >> 14) * (16384 * 1024) + (size_t)(lane >> 3) * (16384 * 128) + (size_t)(row & 16383) * 128 + (lane & 7) * 16) = o;
    if (lane == 0) scale[row] = mx * (1.0f / 127.0f);
  }
}

DI void phase_prep(const Params& p, char* lds, int bid, int nb) {
  char* ws = p.ws;
  float* tl = (float*)lds;
  const int tidx = TIDX;
  transpose_job(p.w_qkv, 1536, (short*)(ws + OFF_WQKVT), p.norm_mix, false, tl, bid, nb, tidx);
  transpose_job(p.w_o, 1024, (short*)(ws + OFF_WOT), nullptr, false, tl, bid, nb, tidx);
  transpose_job(p.w_in, 3072, (short*)(ws + OFF_WINT), p.norm_mix + 1024, true, tl, bid, nb, tidx);
  transpose_job(p.w_out, 1024, (short*)(ws + OFF_WOUTT), nullptr, false, tl, bid, nb, tidx);
  transpose_job(p.w_query, 2048, (short*)(ws + OFF_WQT), p.norm_ffn, false, tl, bid, nb, tidx);
  transpose_job(p.w_query + (size_t)1024 * 2048, 2048, (short*)(ws + OFF_WQT) + (size_t)2048 * 1024, p.norm_ffn + 1024, false, tl, bid, nb, tidx);
  convert_job(p.sub_keys, (short*)(ws + OFF_KEYS), (size_t)2 * 262144 / 8, bid, nb, tidx);
  i8_job(p.peer_u, (unsigned char*)(ws + OFF_UB), (float*)(ws + OFF_SU), 2 * 16384, p.norm_ffn, bid, nb, tidx);
  fp8_job(p.peer_v, (unsigned char*)(ws + OFF_VB), (float*)(ws + OFF_SV), 2 * 16384, nullptr, bid, nb, tidx);
  float* ss = (float*)(ws + OFF_SS);
  for (int i = bid * NTHR + tidx; i < T; i += nb * NTHR) {
    ss[T + i] = 0.f; ss[2 * T + i] = 0.f; ss[3 * T + i] = 0.f;
    const int pos = i >> 3, d = i & 7;
    const float fr[8] = {1.0f, 0.19392274f, 0.03760603f, 0.0072926646f, 0.0014142136f, 0.0002742482f, 5.3182957e-05f, 1.0313385e-05f};
    float f = d == 0 ? fr[0] : d == 1 ? fr[1] : d == 2 ? fr[2] : d == 3 ? fr[3] : d == 4 ? fr[4] : d == 5 ? fr[5] : d == 6 ? fr[6] : fr[7];
    float ang = (float)pos * f;
    ((float2*)(ws + OFF_ROPE))[i] = make_float2((float)cos((double)ang), (float)sin((double)ang));
  }
  {
    const int lane = tidx & 63, gw = bid * NWAVE + (tidx >> 6), nw = nb * NWAVE;
    short* xb = (short*)(ws + OFF_XB);
    for (int tok = gw; tok < T; tok += nw) {
      const float* xr = p.x + (size_t)tok * 1024;
      float s = 0.f;
#pragma unroll
      for (int hh = 0; hh < 2; ++hh) {
        f32x4 a = *(const f32x4*)(xr + hh * 512 + lane * 8), b = *(const f32x4*)(xr + hh * 512 + lane * 8 + 4);
        s += a[0] * a[0] + a[1] * a[1] + a[2] * a[2] + a[3] * a[3] + b[0] * b[0] + b[1] * b[1] + b[2] * b[2] + b[3] * b[3];
        u32x4 o; o[0] = pack2(a[0], a[1]); o[1] = pack2(a[2], a[3]); o[2] = pack2(b[0], b[1]); o[3] = pack2(b[2], b[3]);
        *(u32x4*)(xb + (size_t)tok * 1024 + hh * 512 + lane * 8) = o;
      }
#pragma unroll
      for (int m = 32; m > 0; m >>= 1) s += __shfl_xor(s, m);
      if (lane == 0) ss[tok] = s;
    }
  }
}

enum { EPI_QKV = 0, EPI_RES = 1, EPI_PQ = 2, EPI_CONVIN = 3 };

template <int EPI, int SUB>
DI void epilogue(const Params& p, f32x16 (&acc)[4][2], int fb, int tb, int lane, int layer, bool dry) {
  char* ws = p.ws;
  const int l32 = lane & 31, half = lane >> 5;
  float* ss = (float*)(ws + OFF_SS);
  if (EPI == EPI_QKV) {
    const int hd = fb >> 6;
#pragma unroll
    for (int nt = 0; nt < 2; ++nt) {
      const int tok = tb + nt * 32 + l32, pos = tok & (SEQ - 1), bb = tok >> 12;
      const float rs0 = rsqrtf(ss[tok] * (1.0f / 1024.0f) + EPS);
      if (hd < 20) {
        float sq = 0.f;
#pragma unroll
        for (int mt = 0; mt < 2; ++mt)
#pragma unroll
          for (int r = 0; r < 16; ++r) { float v = acc[2 * SUB + mt][nt][r] * rs0; sq += v * v; }
        sq += __shfl_xor(sq, 32);
        const float rs = rsqrtf(sq * (1.0f / 64.0f) + EPS) * rs0;
        const float* gain = hd < 16 ? p.q_norm : p.k_norm;
        const float sc = hd < 16 ? 0.125f : 1.0f;
        float v[2][16];
#pragma unroll
        for (int mt = 0; mt < 2; ++mt)
#pragma unroll
          for (int r = 0; r < 16; ++r) v[mt][r] = acc[2 * SUB + mt][nt][r] * rs * gain[mt * 32 + crow(r, half)];
        const float2* rt = (const float2*)(ws + OFF_ROPE) + pos * 8 + 4 * half;
#pragma unroll
        for (int r = 0; r < 4; ++r) {
          float2 cs = rt[r];
          float x1 = v[0][r], x2 = v[0][r + 4];
          v[0][r] = x1 * cs.x - x2 * cs.y;
          v[0][r + 4] = x2 * cs.x + x1 * cs.y;
        }
        short* dst = hd < 16 ? (short*)(ws + OFF_Q) + (size_t)tok * 1024 + hd * 64 : (short*)(ws + OFF_K) + (size_t)tok * 256 + (hd - 16) * 64;
#pragma unroll
        for (int mt = 0; mt < 2; ++mt)
#pragma unroll
          for (int g4 = 0; g4 < 4; ++g4) {
            u32x2 o; o[0] = pack2(v[mt][4 * g4] * sc, v[mt][4 * g4 + 1] * sc); o[1] = pack2(v[mt][4 * g4 + 2] * sc, v[mt][4 * g4 + 3] * sc);
            *(u32x2*)(dst + mt * 32 + 8 * g4 + 4 * half) = o;
          }
      } else {
        const int hk = hd - 20;
        unsigned short* vt = (unsigned short*)(ws + OFF_VT) + ((size_t)(bb * 4 + hk) * 64) * SEQ + pos;
#pragma unroll
        for (int mt = 0; mt < 2; ++mt)
#pragma unroll
          for (int r = 0; r < 16; ++r) {
            const int d = mt * 32 + crow(r, half);
            vt[(size_t)d * SEQ] = (unsigned short)(pack2(acc[2 * SUB + mt][nt][r] * rs0, 0.f) & 0xffffu);
          }
      }
    }
  } else if (EPI == EPI_RES) {
    const float* resid = layer == 0 ? p.x : p.out;
    float* ssn = ss + (layer == 0 ? 1 : 3) * T;
    short* xb = (short*)(ws + OFF_XB);
#pragma unroll
    for (int nt = 0; nt < 2; ++nt) {
      const int tok = tb + nt * 32 + l32;
      float sq = 0.f;
#pragma unroll
      for (int mt = 0; mt < 2; ++mt)
#pragma unroll
        for (int g4 = 0; g4 < 4; ++g4) {
          const size_t off = (size_t)tok * 1024 + fb + mt * 32 + 8 * g4 + 4 * half;
          f32x4 r = *(const f32x4*)(resid + off);
          f32x4 o;
#pragma unroll
          for (int j = 0; j < 4; ++j) { o[j] = r[j] + acc[2 * SUB + mt][nt][4 * g4 + j]; sq += o[j] * o[j]; }
          if (!dry) *(f32x4*)(p.out + off) = o;
          u32x2 ob; ob[0] = pack2(o[0], o[1]); ob[1] = pack2(o[2], o[3]);
          *(u32x2*)(xb + off) = ob;
          { int w8 = 0; w8 = __builtin_amdgcn_cvt_pk_fp8_f32(o[0], o[1], w8, false); w8 = __builtin_amdgcn_cvt_pk_fp8_f32(o[2], o[3], w8, true); *(int*)(ws + OFF_X8 + off) = w8; }
        }
      sq += __shfl_xor(sq, 32);
      if (half == 0 && !dry) unsafeAtomicAdd(ssn + tok, sq);
    }
  } else if (EPI == EPI_PQ) {
    const float* ssc = ss + (layer == 0 ? 1 : 3) * T;
    short* pq = (short*)(ws + OFF_PQ);
#pragma unroll
    for (int nt = 0; nt < 2; ++nt) {
      const int tok = tb + nt * 32 + l32;
      const float rs = rsqrtf(ssc[tok] * (1.0f / 1024.0f) + EPS);
#pragma unroll
      for (int mt = 0; mt < 2; ++mt)
#pragma unroll
        for (int g4 = 0; g4 < 4; ++g4) {
          u32x2 o; o[0] = pack2(acc[2 * SUB + mt][nt][4 * g4] * rs, acc[2 * SUB + mt][nt][4 * g4 + 1] * rs);
          o[1] = pack2(acc[2 * SUB + mt][nt][4 * g4 + 2] * rs, acc[2 * SUB + mt][nt][4 * g4 + 3] * rs);
          *(u32x2*)(pq + (size_t)tok * 2048 + fb + mt * 32 + 8 * g4 + 4 * half) = o;
        }
    }
  } else {
    const float* ssc = ss + 2 * T;
#pragma unroll
    for (int nt = 0; nt < 2; ++nt) {
      const int tok = tb + nt * 32 + l32;
      const float rs = rsqrtf(ssc[tok] * (1.0f / 1024.0f) + EPS);
      if (fb < 1024) {
        short* cb = (short*)(ws + OFF_CB);
#pragma unroll
        for (int mt = 0; mt < 2; ++mt)
#pragma unroll
          for (int g4 = 0; g4 < 4; ++g4) {
            u32x2 o; o[0] = pack2(acc[2 * SUB + mt][nt][4 * g4] * rs, acc[2 * SUB + mt][nt][4 * g4 + 1] * rs);
            o[1] = pack2(acc[2 * SUB + mt][nt][4 * g4 + 2] * rs, acc[2 * SUB + mt][nt][4 * g4 + 3] * rs);
            *(u32x2*)(cb + (size_t)tok * 1024 + fb + mt * 32 + 8 * g4 + 4 * half) = o;
          }
      } else {
        const int w = fb - 1024;
        const int chb = (w >> 7) * 64 + ((w >> 6) & 1) * 32;
        short* cz = (short*)(ws + OFF_CZ);
        const float rs2 = rs * rs;
#pragma unroll
        for (int g4 = 0; g4 < 4; ++g4) {
          float z0 = acc[2 * SUB][nt][4 * g4] * acc[2 * SUB + 1][nt][4 * g4] * rs2, z1 = acc[2 * SUB][nt][4 * g4 + 1] * acc[2 * SUB + 1][nt][4 * g4 + 1] * rs2;
          float z2 = acc[2 * SUB][nt][4 * g4 + 2] * acc[2 * SUB + 1][nt][4 * g4 + 2] * rs2, z3 = acc[2 * SUB][nt][4 * g4 + 3] * acc[2 * SUB + 1][nt][4 * g4 + 3] * rs2;
          u32x2 o; o[0] = pack2(z0, z1); o[1] = pack2(z2, z3);
          *(u32x2*)(cz + (size_t)tok * 1024 + chb + 8 * g4 + 4 * half) = o;
        }
      }
    }
  }
}

typedef __attribute__((ext_vector_type(4))) float f32x4v;
constexpr int G_HT = 128 * 64;
DI int g_lds_byte(int r, int c) { int st = (r >> 4) * 2 + (c >> 5), rr = r & 15, cc = c & 31, ob = rr * 64 + cc * 2; return st * 1024 + (ob ^ (((ob >> 9) & 1) << 5)); }
DI void g_stage_rc(int b, int& R, int& C) { int st = b / 1024, sb = b % 1024, swz = sb ^ (((sb >> 9) & 1) << 5); R = (st >> 1) * 16 + swz / 64; C = (st & 1) * 32 + (swz % 64) / 2; }

template <int NM>
DI void wave_store_rows(char* lb, const u32x2 (&v)[2][4], int lane, short* dst, size_t pitch) {
  const int fr = lane & 15, fq = lane >> 4;
#pragma unroll
  for (int n = 0; n < 2; ++n)
#pragma unroll
    for (int m = 0; m < NM; ++m) *(u32x2*)(lb + (n * 16 + fr) * 144 + m * 32 + fq * 8) = v[n][m];
  constexpr int LPR = NM * 2, RPI = 64 / LPR;
  const int rsub = lane / LPR, ch = lane % LPR;
#pragma unroll
  for (int it = 0; it < 32 / RPI; ++it) {
    const int row = it * RPI + rsub;
    const u32x4 x = *(const u32x4*)(lb + row * 144 + ch * 16);
    *(u32x4*)(dst + (size_t)row * pitch + ch * 8) = x;
  }
}

template <int EPI>
DI void epilogue8(const Params& p, f32x4v (&acc)[2][2][4][2], char* lb, int fb0, int tb0, int lane, int layer, bool dry) {
  char* ws = p.ws;
  const int fr = lane & 15, fq = lane >> 4;
  float* ss = (float*)(ws + OFF_SS);
#pragma unroll
  for (int ai = 0; ai < 2; ++ai) {
    const int fb = fb0 + ai * 128;
#pragma unroll
    for (int bj = 0; bj < 2; ++bj) {
      const int tbase = tb0 + bj * 128;
      u32x2 ov[2][4];
      if (EPI == EPI_QKV) {
        const int hd = fb >> 6;
        if (hd < 20) {
#pragma unroll
          for (int n = 0; n < 2; ++n) {
            const int tok = tbase + n * 16 + fr, pos = tok & (SEQ - 1);
            const float rs0 = rsqrtf(ss[tok] * (1.0f / 1024.0f) + EPS);
            float sq = 0.f;
#pragma unroll
            for (int m = 0; m < 4; ++m)
#pragma unroll
              for (int j = 0; j < 4; ++j) { float v = acc[ai][bj][m][n][j] * rs0; sq += v * v; }
            sq += __shfl_xor(sq, 16);
            sq += __shfl_xor(sq, 32);
            const float rs = rsqrtf(sq * (1.0f / 64.0f) + EPS) * rs0;
            const float* gain = hd < 16 ? p.q_norm : p.k_norm;
            const float sc = hd < 16 ? 0.125f : 1.0f;
            const float2* rt = (const float2*)(ws + OFF_ROPE) + pos * 8 + 4 * (fq & 1);
#pragma unroll
            for (int m = 0; m < 4; ++m) {
              const f32x4 gv = *(const f32x4*)(gain + m * 16 + fq * 4);
              float v[4];
#pragma unroll
              for (int j = 0; j < 4; ++j) v[j] = acc[ai][bj][m][n][j] * rs * gv[j];
              if (m == 0) {
#pragma unroll
                for (int j = 0; j < 4; ++j) {
                  const float mine = v[j], other = __shfl_xor(mine, 32);
                  const float2 cs = rt[j];
                  v[j] = (fq < 2) ? (mine * cs.x - other * cs.y) : (mine * cs.x + other * cs.y);
                }
              }
              ov[n][m][0] = pack2(v[0] * sc, v[1] * sc); ov[n][m][1] = pack2(v[2] * sc, v[3] * sc);
            }
          }
          short* dst = hd < 16 ? (short*)(ws + OFF_Q) + (size_t)tbase * 1024 + hd * 64 : (short*)(ws + OFF_K) + (size_t)tbase * 256 + (hd - 16) * 64;
          wave_store_rows<4>(lb, ov, lane, dst, hd < 16 ? 1024 : 256);
        } else {
          const int hk = hd - 20;
#pragma unroll
          for (int n = 0; n < 2; ++n) {
            const int tok = tbase + n * 16 + fr;
            const float rs0 = rsqrtf(ss[tok] * (1.0f / 1024.0f) + EPS);
#pragma unroll
            for (int m = 0; m < 4; ++m)
#pragma unroll
              for (int j = 0; j < 4; ++j)
                *(unsigned short*)(lb + (m * 16 + fq * 4 + j) * 80 + (n * 16 + fr) * 2) = (unsigned short)(pack2(acc[ai][bj][m][n][j] * rs0, 0.f) & 0xffffu);
          }
          const int bb = tbase >> 12, pos0 = tbase & (SEQ - 1);
          unsigned short* vt = (unsigned short*)(ws + OFF_VT) + ((size_t)(bb * 4 + hk) * 64) * SEQ + pos0;
          const int rsub = lane >> 2, ch = lane & 3;
#pragma unroll
          for (int it = 0; it < 4; ++it) {
            const int d = it * 16 + rsub;
            const u32x4 x = *(const u32x4*)(lb + d * 80 + ch * 16);
            *(u32x4*)(vt + (size_t)d * SEQ + ch * 8) = x;
          }
        }
      } else if (EPI == EPI_RES) {
        float* ssn = ss + (layer == 0 ? 1 : 3) * T;
        const short* xbr = (const short*)(ws + OFF_XB);
#pragma unroll
        for (int n = 0; n < 2; ++n) {
          const int tok = tbase + n * 16 + fr;
          float sq = 0.f;
#pragma unroll
          for (int m = 0; m < 4; ++m) {
            const size_t off = (size_t)tok * 1024 + fb + m * 16 + fq * 4;
            f32x4 r;
            { const u32x2 rb = *(const u32x2*)(xbr + off); r[0] = bflo(rb[0]); r[1] = bfhi(rb[0]); r[2] = bflo(rb[1]); r[3] = bfhi(rb[1]); }
            f32x4 o;
#pragma unroll
            for (int j = 0; j < 4; ++j) { o[j] = r[j] + acc[ai][bj][m][n][j]; sq += o[j] * o[j]; }
            ov[n][m][0] = pack2(o[0], o[1]); ov[n][m][1] = pack2(o[2], o[3]);
          }
          sq += __shfl_xor(sq, 16);
          sq += __shfl_xor(sq, 32);
          if (fq == 0 && !dry) unsafeAtomicAdd(ssn + tok, sq);
        }
        if (!dry) wave_store_rows<4>(lb, ov, lane, (short*)(ws + OFF_XB) + (size_t)tbase * 1024 + fb, 1024);
      } else if (EPI == EPI_PQ) {
        const float* ssc = ss + (layer == 0 ? 1 : 3) * T;
#pragma unroll
        for (int n = 0; n < 2; ++n) {
          const int tok = tbase + n * 16 + fr;
          const float rs = rsqrtf(ssc[tok] * (1.0f / 1024.0f) + EPS);
#pragma unroll
          for (int m = 0; m < 4; ++m) {
            ov[n][m][0] = pack2(acc[ai][bj][m][n][0] * rs, acc[ai][bj][m][n][1] * rs);
            ov[n][m][1] = pack2(acc[ai][bj][m][n][2] * rs, acc[ai][bj][m][n][3] * rs);
          }
        }
        wave_store_rows<4>(lb, ov, lane, (short*)(ws + OFF_PQ) + (size_t)tbase * 2048 + fb, 2048);
      } else {
        const bool isb = fb < 1024;
#pragma unroll
        for (int n = 0; n < 2; ++n) {
          const int tok = tbase + n * 16 + fr;
          const float rs = rsqrtf(ss[2 * T + tok] * (1.0f / 1024.0f) + EPS);
          if (isb) {
#pragma unroll
            for (int m = 0; m < 4; ++m) {
              ov[n][m][0] = pack2(acc[ai][bj][m][n][0] * rs, acc[ai][bj][m][n][1] * rs);
              ov[n][m][1] = pack2(acc[ai][bj][m][n][2] * rs, acc[ai][bj][m][n][3] * rs);
            }
          } else {
            const float rs2 = rs * rs;
#pragma unroll
            for (int m = 0; m < 2; ++m) {
              ov[n][m][0] = pack2(acc[ai][bj][m][n][0] * acc[ai][bj][m + 2][n][0] * rs2, acc[ai][bj][m][n][1] * acc[ai][bj][m + 2][n][1] * rs2);
              ov[n][m][1] = pack2(acc[ai][bj][m][n][2] * acc[ai][bj][m + 2][n][2] * rs2, acc[ai][bj][m][n][3] * acc[ai][bj][m + 2][n][3] * rs2);
              ov[n][m + 2][0] = 0; ov[n][m + 2][1] = 0;
            }
          }
        }
        if (isb) wave_store_rows<4>(lb, ov, lane, (short*)(ws + OFF_CB) + (size_t)tbase * 1024 + fb, 1024);
        else {
          const int w = fb - 1024;
          const int chb = (w >> 7) * 64 + ((w >> 6) & 1) * 32;
          wave_store_rows<2>(lb, ov, lane, (short*)(ws + OFF_CZ) + (size_t)tbase * 1024 + chb, 1024);
        }
      }
    }
  }
}

template <int EPI>
DI void gemm_phase(const Params& p, const short* __restrict__ A, const short* __restrict__ Bt, int Mfeat, char* lds, int vb, int nb, int layer, bool dry = false, int variant = 0) {
  short* shm = (short*)lds;
  constexpr int K = 1024, BK = 64, HALF = 128, nt = K / BK;
#define SA(b, h) (shm + ((b) * 2 + (h)) * G_HT)
#define SB_(b, h) (shm + (4 + (b) * 2 + (h)) * G_HT)
#define STAGE(P, BASE, br, kt) do { const unsigned _o = soff + (unsigned)(((br) * K + (kt) * BK) * 2); \
    __builtin_amdgcn_global_load_lds((const unsigned*)((const char*)(BASE) + (size_t)_o), (unsigned*)((char*)(P) + tidx * 16), 16, 0, 0); \
    __builtin_amdgcn_global_load_lds((const unsigned*)((const char*)(BASE) + (size_t)(_o + 64u * K * 2u)), (unsigned*)((char*)(P) + tidx * 16 + 8192), 16, 0, 0); } while (0)
#define LDA(dst, b, h) _Pragma("unroll") for (int m = 0; m < 4; ++m) _Pragma("unroll") for (int k = 0; k < 2; ++k) \
    dst[m][k] = *reinterpret_cast<const bf16x8*>((char*)SA(b, h) + g_lds_byte(wr * 64 + m * 16 + fr, k * 32 + fq * 8))
#define LDB(dst, b, h) _Pragma("unroll") for (int n = 0; n < 2; ++n) _Pragma("unroll") for (int k = 0; k < 2; ++k) \
    dst[n][k] = *reinterpret_cast<const bf16x8*>((char*)SB_(b, h) + g_lds_byte(wc * 32 + n * 16 + fr, k * 32 + fq * 8))
#define MMA(ai, bj, At_, Bt_) do { __builtin_amdgcn_s_setprio(1); \
    _Pragma("unroll") for (int m = 0; m < 4; ++m) _Pragma("unroll") for (int n = 0; n < 2; ++n) _Pragma("unroll") for (int k = 0; k < 2; ++k) \
      acc[ai][bj][m][n] = __builtin_amdgcn_mfma_f32_16x16x32_bf16(At_[m][k], Bt_[n][k], acc[ai][bj][m][n], 0, 0, 0); \
    __builtin_amdgcn_s_setprio(0); } while (0)
#define WAIT_V(n) asm volatile("s_waitcnt vmcnt(" #n ")" ::: "memory")
#define WAIT_L(n) asm volatile("s_waitcnt lgkmcnt(" #n ")" ::: "memory")
#define BAR __builtin_amdgcn_s_barrier()
#define SCHED __builtin_amdgcn_sched_barrier(0)
  const int tidx = TIDX;
  const int wid = tidx >> 6, lane = tidx & 63, wr = wid >> 2, wc = wid & 3, fr = lane & 15, fq = lane >> 4;
  int sR, sC;
  g_stage_rc(tidx * 16, sR, sC);
  const unsigned soff = (unsigned)(sR * K + sC) * 2u;
  const int mtiles = Mfeat >> 8;
  const int ntiles = mtiles * (T / 256);
  for (int tile = vb; tile < ntiles; tile += nb) {
    const int tm = tile % mtiles, tn = tile / mtiles;
    const int brow = tm << 8, bcol = tn << 8;
    f32x4v acc[2][2][4][2];
#pragma unroll
    for (int a = 0; a < 2; ++a)
#pragma unroll
      for (int b = 0; b < 2; ++b)
#pragma unroll
        for (int m = 0; m < 4; ++m)
#pragma unroll
          for (int n = 0; n < 2; ++n) acc[a][b][m][n] = f32x4v{0.f, 0.f, 0.f, 0.f};
    bf16x8 At[4][2], B0[2][2], B1[2][2];
    STAGE(SB_(0, 0), Bt, bcol, 0); STAGE(SA(0, 0), A, brow, 0);
    STAGE(SB_(0, 1), Bt, bcol + HALF, 0); STAGE(SA(0, 1), A, brow + HALF, 0);
    if (wr == 1) BAR;
    WAIT_V(4); BAR;
    STAGE(SB_(1, 0), Bt, bcol, 1); STAGE(SA(1, 0), A, brow, 1); STAGE(SB_(1, 1), Bt, bcol + HALF, 1);
    WAIT_V(6); BAR;
    for (int t = 0; t < nt - 2; t += 2) {
      LDB(B0, 0, 0); SCHED; LDA(At, 0, 0); STAGE(SA(1, 1), A, brow + HALF, t + 1);
      WAIT_L(8); BAR; WAIT_L(0); MMA(0, 0, At, B0); BAR; SCHED;
      LDB(B1, 0, 1); STAGE(SB_(0, 0), Bt, bcol, t + 2);
      BAR; WAIT_L(0); MMA(0, 1, At, B1); BAR;
      LDA(At, 0, 1); STAGE(SA(0, 0), A, brow, t + 2);
      BAR; WAIT_L(0); MMA(1, 0, At, B0); BAR; SCHED;
      STAGE(SB_(0, 1), Bt, bcol + HALF, t + 2);
      WAIT_V(6); BAR; MMA(1, 1, At, B1); BAR;
      LDB(B0, 1, 0); SCHED; LDA(At, 1, 0); STAGE(SA(0, 1), A, brow + HALF, t + 2);
      WAIT_L(8); BAR; WAIT_L(0); MMA(0, 0, At, B0); BAR; SCHED;
      LDB(B1, 1, 1); STAGE(SB_(1, 0), Bt, bcol, t + 3);
      BAR; WAIT_L(0); MMA(0, 1, At, B1); BAR;
      LDA(At, 1, 1); STAGE(SA(1, 0), A, brow, t + 3);
      BAR; WAIT_L(0); MMA(1, 0, At, B0); BAR; SCHED;
      STAGE(SB_(1, 1), Bt, bcol + HALF, t + 3);
      WAIT_V(6); BAR; MMA(1, 1, At, B1); BAR;
    }
    { LDB(B0, 0, 0); LDA(At, 0, 0); STAGE(SA(1, 1), A, brow + HALF, nt - 1);
      BAR; WAIT_L(0); MMA(0, 0, At, B0); BAR;
      LDB(B1, 0, 1); BAR; WAIT_L(0); MMA(0, 1, At, B1); BAR;
      LDA(At, 0, 1); WAIT_V(4); BAR; WAIT_L(0); MMA(1, 0, At, B0); MMA(1, 1, At, B1); BAR; }
    { LDB(B0, 1, 0); LDA(At, 1, 0); WAIT_V(2); BAR; WAIT_L(0); MMA(0, 0, At, B0); BAR;
      LDB(B1, 1, 1); WAIT_V(0); BAR; WAIT_L(0); MMA(0, 1, At, B1); BAR;
      LDA(At, 1, 1); BAR; WAIT_L(0); MMA(1, 0, At, B0); MMA(1, 1, At, B1); BAR; }
    if (wr == 0) BAR;
    __builtin_amdgcn_sched_barrier(0);
    epilogue8<EPI>(p, acc, lds + wid * 5120, brow + wr * 64, bcol + wc * 32, lane, layer, dry);
    WAIT_V(0);
    __syncthreads();
  }
  __syncthreads();
}

constexpr int AK_PITCH = 144;
constexpr int AV_PITCH = 528;
constexpr int AV_OFF = 256 * AK_PITCH;
DI void phase_attn(const Params& p, char* lds, int bid, int nb) {
  char* ws = p.ws;
  const int lane = lane_id(), wid = p.wv, l32 = lane & 31, half = lane >> 5;
  const int tidx = wid * 64 + lane;
  const short* qbuf = (const short*)(ws + OFF_Q);
  const short* kbuf = (const short*)(ws + OFF_K);
  const short* vtb = (const short*)(ws + OFF_VT);
  short* obuf = (short*)(ws + OFF_O);
  for (int blk = bid; blk < 1024; blk += nb) {
    const int hkv = blk & 3, n = (blk >> 2) & 31, b = blk >> 7;
    const int kbase = n * 128 - 128;
    __syncthreads();
#pragma unroll
    for (int i = 0; i < 4; ++i) {
      const int id = tidx + NTHR * i;
      const int key = id >> 3, ch = id & 7;
      if (kbase + key >= 0) *(u32x4*)(lds + key * AK_PITCH + ch * 16) = *(const u32x4*)(kbuf + (size_t)(b * SEQ + kbase + key) * 256 + hkv * 64 + ch * 8);
      const int d = id >> 5, vc = id & 31;
      if (kbase + vc * 8 >= 0) *(u32x4*)(lds + AV_OFF + d * AV_PITCH + vc * 16) = *(const u32x4*)(vtb + ((size_t)(b * 4 + hkv) * 64 + d) * SEQ + kbase + vc * 8);
    }
    __syncthreads();
    const int head = hkv * 4 + (wid & 3);
    const float sink = p.sinks[head];
#pragma unroll 1
    for (int cc = 0; cc < 2; ++cc) {
      const int c = (wid >> 2) * 2 + cc;
      const int qtok = b * SEQ + n * 128 + c * 32 + l32;
      bf16x8 qf[4];
#pragma unroll
      for (int ks = 0; ks < 4; ++ks) qf[ks] = *(const bf16x8*)(qbuf + (size_t)qtok * 1024 + head * 64 + ks * 16 + half * 8);
      f32x16 s[5];
      const int jt0 = (n == 0) ? (4 - c) : 0;
#pragma unroll
      for (int jt = 0; jt < 5; ++jt) {
#pragma unroll
        for (int r = 0; r < 16; ++r) s[jt][r] = 0.f;
        if (jt >= jt0) {
          const char* kp = lds + (32 * (c + jt) + l32) * AK_PITCH + half * 16;
#pragma unroll
          for (int ks = 0; ks < 4; ++ks) {
            bf16x8 kf = *(const bf16x8*)(kp + ks * 32);
            s[jt] = MFMA32(kf, qf[ks], s[jt]);
          }
        }
      }
      float m = sink;
#pragma unroll
      for (int jt = 0; jt < 5; ++jt)
#pragma unroll
        for (int r = 0; r < 16; ++r) {
          const int kr = crow(r, half);
          bool valid = jt >= jt0;
          if (jt == 0) valid = valid && (kr > l32);
          if (jt == 4) valid = valid && (kr <= l32);
          float v = valid ? s[jt][r] : -1e30f;
          s[jt][r] = v;
          m = fmaxf(m, v);
        }
      m = fmaxf(m, __shfl_xor(m, 32));
      float sum = 0.f;
#pragma unroll
      for (int jt = 0; jt < 5; ++jt)
#pragma unroll
        for (int r = 0; r < 16; ++r) { float e = __expf(s[jt][r] - m); s[jt][r] = e; sum += e; }
      sum += __shfl_xor(sum, 32);
      const float inv = 1.0f / (sum + __expf(sink - m));
      f32x16 o[2];
#pragma unroll
      for (int dt = 0; dt < 2; ++dt)
#pragma unroll
        for (int r = 0; r < 16; ++r) o[dt][r] = 0.f;
#pragma unroll
      for (int jt = 0; jt < 5; ++jt) {
        if (jt >= jt0) {
#pragma unroll
          for (int s2 = 0; s2 < 2; ++s2) {
            u32x4 pf;
            pf[0] = pack2(s[jt][8 * s2 + 0], s[jt][8 * s2 + 1]); pf[1] = pack2(s[jt][8 * s2 + 2], s[jt][8 * s2 + 3]);
            pf[2] = pack2(s[jt][8 * s2 + 4], s[jt][8 * s2 + 5]); pf[3] = pack2(s[jt][8 * s2 + 6], s[jt][8 * s2 + 7]);
            bf16x8 pb = __builtin_bit_cast(bf16x8, pf);
#pragma unroll
            for (int dt = 0; dt < 2; ++dt) {
              const char* vp = lds + AV_OFF + (dt * 32 + l32) * AV_PITCH + (32 * (c + jt) + 16 * s2 + 4 * half) * 2;
              u32x2 v0 = *(const u32x2*)(vp), v1 = *(const u32x2*)(vp + 16);
              u32x4 vf; vf[0] = v0[0]; vf[1] = v0[1]; vf[2] = v1[0]; vf[3] = v1[1];
              o[dt] = MFMA32(__builtin_bit_cast(bf16x8, vf), pb, o[dt]);
            }
          }
        }
      }
#pragma unroll
      for (int dt = 0; dt < 2; ++dt)
#pragma unroll
        for (int g4 = 0; g4 < 4; ++g4) {
          u32x2 ob; ob[0] = pack2(o[dt][4 * g4] * inv, o[dt][4 * g4 + 1] * inv); ob[1] = pack2(o[dt][4 * g4 + 2] * inv, o[dt][4 * g4 + 3] * inv);
          *(u32x2*)(obuf + (size_t)qtok * 1024 + head * 64 + dt * 32 + 8 * g4 + 4 * half) = ob;
        }
    }
  }
}

DI int f2key(float f) { int i = __float_as_int(f); return i ^ ((i >> 31) & 0x7fffffff); }
DI float key2f(int k) { return __int_as_float(k ^ ((k >> 31) & 0x7fffffff)); }
#define CEX(a, b) { int _hi = max((a), (b)); int _lo = min((a), (b)); (a) = _hi; (b) = _lo; }

DI void merge16_desc(int (&v)[16]) {
#pragma unroll
  for (int j = 8; j > 0; j >>= 1)
#pragma unroll
    for (int i = 0; i < 16; ++i) { const int l = i ^ j; if (l > i) CEX(v[i], v[l]); }
}
DI void sort16_desc(int (&v)[16]) {
#pragma unroll
  for (int k = 2; k <= 16; k <<= 1)
#pragma unroll
    for (int j = k >> 1; j > 0; j >>= 1)
#pragma unroll
      for (int i = 0; i < 16; ++i) {
        const int l = i ^ j;
        if (l > i) { if ((i & k) == 0) CEX(v[i], v[l]) else CEX(v[l], v[i]); }
      }
}
constexpr unsigned char CAND_I[50] = {0,0,0,0,0,0,0,0,0,0,0,0,0,0,0,0,1,1,1,1,1,1,1,1,2,2,2,2,2,3,3,3,3,4,4,4,5,5,6,6,7,7,8,9,10,11,12,13,14,15};
constexpr unsigned char CAND_J[50] = {0,1,2,3,4,5,6,7,8,9,10,11,12,13,14,15,0,1,2,3,4,5,6,7,0,1,2,3,4,0,1,2,3,0,1,2,0,1,0,1,0,1,0,0,0,0,0,0,0,0};
DI void sort32_desc(int (&v)[32]) {
#pragma unroll
  for (int k = 2; k <= 32; k <<= 1)
#pragma unroll
    for (int j = k >> 1; j > 0; j >>= 1)
#pragma unroll
      for (int i = 0; i < 32; ++i) {
        const int l = i ^ j;
        if (l > i) { if ((i & k) == 0) CEX(v[i], v[l]) else CEX(v[l], v[i]); }
      }
}
DI void topmerge(int (&a)[16], const int (&b)[16]) {
#pragma unroll
  for (int i = 0; i < 16; ++i) a[i] = max(a[i], b[15 - i]);
  merge16_desc(a);
}
DI int sel16(const int (&L)[16], int i) {
  int r = L[0];
#pragma unroll
  for (int q = 1; q < 16; ++q) r = (i == q) ? L[q] : r;
  return r;
}

DI void score_half(const short* __restrict__ pq, const char* klds, int tok, int h, int ph, int l32, int half, int (&top)[16]) {
  bf16x8 qf[8];
#pragma unroll
  for (int ks = 0; ks < 8; ++ks) qf[ks] = *(const bf16x8*)(pq + (size_t)tok * 2048 + h * 256 + ph * 128 + ks * 16 + half * 8);
  const char* kb = klds + l32 * 272 + half * 16;
#pragma unroll 1
  for (int kt = 0; kt < 4; ++kt) {
    f32x16 acc;
#pragma unroll
    for (int r = 0; r < 16; ++r) acc[r] = 0.f;
#pragma unroll
    for (int ks = 0; ks < 8; ++ks) {
      bf16x8 kf = *(const bf16x8*)(kb + kt * 32 * 272 + ks * 32);
      acc = MFMA32(kf, qf[ks], acc);
    }
    int t2[16];
#pragma unroll
    for (int r = 0; r < 16; ++r) t2[r] = (f2key(acc[r]) & ~127) | (kt * 32 + crow(r, half));
    sort16_desc(t2);
    if (kt == 0) {
#pragma unroll
      for (int r = 0; r < 16; ++r) top[r] = t2[r];
    } else topmerge(top, t2);
  }
  int t3[16];
#pragma unroll
  for (int r = 0; r < 16; ++r) t3[r] = __shfl_xor(top[r], 32);
  topmerge(top, t3);
}

DI void phase_score(const Params& p, int layer, char* lds, int bid, int nb) {
  char* ws = p.ws;
  const int lane = lane_id(), wid = p.wv, l32 = lane & 31, half = lane >> 5;
  const short* pq = (const short*)(ws + OFF_PQ);
  const short* keys = (const short*)(ws + OFF_KEYS) + (size_t)layer * 262144;
  int* idxo = (int*)(ws + OFF_IDX);
  float* go = (float*)(ws + OFF_G);
  char* klds = lds + NWAVE * 8192;
  const int tidx = wid * 64 + lane;
  constexpr int KT_BYTES = 128 * 272;
  int hst = -1;
  for (int blk = bid; blk < 8192 / NWAVE; blk += nb) {
    const int h = blk & 7, tt = (blk >> 3) * NWAVE + wid;
    const int tok = tt * 32 + l32;
    {
      const float* ssq = (const float*)(ws + OFF_SS) + (layer == 0 ? 1 : 3) * T;
      const float qs = rsqrtf(ssq[tok] * (1.0f / 1024.0f) + EPS) * (127.0f / 6.0f);
      const short* xr = (const short*)(ws + OFF_XB) + (size_t)tok * 1024 + h * 128 + half * 64;
      unsigned char* xo = (unsigned char*)(ws + OFF_X8) + (size_t)tok * 1024 + h * 128 + half * 64;
#pragma unroll
      for (int q4 = 0; q4 < 4; ++q4) {
        u32x4 xa = *(const u32x4*)(xr + q4 * 16), xc = *(const u32x4*)(xr + q4 * 16 + 8);
        u32x4 o;
#pragma unroll
        for (int d = 0; d < 4; ++d) {
          const unsigned w0 = d < 2 ? xa[2 * d] : xc[2 * d - 4], w1 = d < 2 ? xa[2 * d + 1] : xc[2 * d - 3];
          const float f0 = __builtin_amdgcn_fmed3f(bflo(w0) * qs, -127.f, 127.f) + 12582912.0f, f1 = __builtin_amdgcn_fmed3f(bfhi(w0) * qs, -127.f, 127.f) + 12582912.0f;
          const float f2 = __builtin_amdgcn_fmed3f(bflo(w1) * qs, -127.f, 127.f) + 12582912.0f, f3 = __builtin_amdgcn_fmed3f(bfhi(w1) * qs, -127.f, 127.f) + 12582912.0f;
          o[d] = (__float_as_uint(f0) & 0xffu) | ((__float_as_uint(f1) & 0xffu) << 8) | ((__float_as_uint(f2) & 0xffu) << 16) | (__float_as_uint(f3) << 24);
        }
        *(u32x4*)(xo + q4 * 16) = o;
      }
    }
    if (h != hst) {
      __syncthreads();
#pragma unroll
      for (int i = 0; i < 8; ++i) {
        const int id = tidx + NTHR * i;
        *(u32x4*)(klds + (id >> 11) * KT_BYTES + ((id >> 4) & 127) * 272 + (id & 15) * 16) = *(const u32x4*)(keys + (size_t)h * 32768 + (size_t)(id >> 4) * 128 + (id & 15) * 8);
      }
      __syncthreads();
      hst = h;
    }
    int L0[16], L1[16];
    score_half(pq, klds, tok, h, 0, l32, half, L0);
    score_half(pq, klds + KT_BYTES, tok, h, 1, l32, half, L1);
    float v1[16], v2[16];
#pragma unroll
    for (int r = 0; r < 16; ++r) { v1[r] = key2f(L0[r] & ~127); v2[r] = key2f(L1[r] & ~127); }
    int cand[32];
#pragma unroll
    for (int sI = 0; sI < 25; ++sI) {
      const float va = v1[CAND_I[2 * sI]] + v2[CAND_J[2 * sI]], vb2 = v1[CAND_I[2 * sI + 1]] + v2[CAND_J[2 * sI + 1]];
      const int ca = CAND_I[2 * sI] * 16 + CAND_J[2 * sI], cb = CAND_I[2 * sI + 1] * 16 + CAND_J[2 * sI + 1];
      cand[sI] = (f2key(half ? vb2 : va) & ~255) | (half ? cb : ca);
    }
#pragma unroll
    for (int sI = 25; sI < 32; ++sI) cand[sI] = (int)0x80000000;
    sort32_desc(cand);
    int best[16], bo[16];
#pragma unroll
    for (int r = 0; r < 16; ++r) { best[r] = cand[r]; bo[r] = __shfl_xor(cand[r], 32); }
    topmerge(best, bo);
    int* lw = (int*)lds + wid * 2048 + lane;
#pragma unroll
    for (int r = 0; r < 16; ++r) { lw[r * 64] = L0[r] & 127; lw[(16 + r) * 64] = L1[r] & 127; }
    float sv[16]; int eid[16];
#pragma unroll
    for (int q = 0; q < 16; ++q) {
      const int code = best[q] & 255;
      sv[q] = key2f(best[q] & ~255);
      const int e1 = lw[(code >> 4) * 64], e2 = lw[(16 + (code & 15)) * 64];
      eid[q] = e1 * 128 + e2;
    }
    float sum = 0.f;
    const float mx = sv[0];
#pragma unroll
    for (int q = 0; q < 16; ++q) { sv[q] = __expf(sv[q] - mx); sum += sv[q]; }
    const float inv = 1.0f / sum;
    const size_t ob = ((size_t)tok * 8 + h) * 16;
    const float* sut = (const float*)(ws + OFF_SU) + layer * 16384;
    const float* svt = (const float*)(ws + OFF_SV) + layer * 16384;
    float* suo = (float*)(ws + OFF_SUV);
    if (half == 0) {
#pragma unroll
      for (int q4 = 0; q4 < 4; ++q4) {
        i32x4 o = {eid[4 * q4], eid[4 * q4 + 1], eid[4 * q4 + 2], eid[4 * q4 + 3]}; *(i32x4*)(idxo + ob + 4 * q4) = o;
        f32x4 o2 = {sut[eid[4 * q4]], sut[eid[4 * q4 + 1]], sut[eid[4 * q4 + 2]], sut[eid[4 * q4 + 3]]}; *(f32x4*)(suo + ob + 4 * q4) = o2;
      }
    } else {
#pragma unroll
      for (int q4 = 0; q4 < 4; ++q4) {
        f32x4 o = {sv[4 * q4] * inv * svt[eid[4 * q4]], sv[4 * q4 + 1] * inv * svt[eid[4 * q4 + 1]], sv[4 * q4 + 2] * inv * svt[eid[4 * q4 + 2]], sv[4 * q4 + 3] * inv * svt[eid[4 * q4 + 3]]};
        *(f32x4*)(go + ob + 4 * q4) = o;
      }
    }
  }
}

DI void gu_issue(const unsigned char* __restrict__ ub, const unsigned char* __restrict__ x8, const int* idw, int tok, int i, int j, int g, int c,
                 u32x4 (&r)[16], u32x4& hx) {
  i32x4 id[4];
#pragma unroll
  for (int q = 0; q < 4; ++q) id[q] = *(const i32x4*)(idw + i * 128 + g * 16 + 4 * q);
  const unsigned so = (unsigned)(j * (16384 * 128) + 16 * c);
#pragma unroll
  for (int b = 0; b < 16; ++b) r[b] = *(const u32x4*)(ub + (size_t)((unsigned)id[b >> 2][b & 3] + so));
  hx = *(const u32x4*)(x8 + (size_t)tok * 1024 + 128 * j + 16 * c);
}
DI void gu_compute(int* accw, int i, int g, int c, int lane, const u32x4 (&r)[16], const u32x4& hx) {
  int pd[16];
#pragma unroll
  for (int b = 0; b < 16; ++b) {
    int acc = __builtin_amdgcn_sdot4((int)r[b][0], (int)hx[0], 0, false);
    acc = __builtin_amdgcn_sdot4((int)r[b][1], (int)hx[1], acc, false);
    acc = __builtin_amdgcn_sdot4((int)r[b][2], (int)hx[2], acc, false);
    pd[b] = __builtin_amdgcn_sdot4((int)r[b][3], (int)hx[3], acc, false);
  }
  const bool b2 = lane & 4, b1 = lane & 2, b0 = lane & 1;
  int q8[8], q4[4], q2[2];
#pragma unroll
  for (int k = 0; k < 8; ++k) { int snd = b2 ? pd[k] : pd[k + 8]; int kp = b2 ? pd[k + 8] : pd[k]; q8[k] = kp + __shfl_xor(snd, 4); }
#pragma unroll
  for (int k = 0; k < 4; ++k) { int snd = b1 ? q8[k] : q8[k + 4]; int kp = b1 ? q8[k + 4] : q8[k]; q4[k] = kp + __shfl_xor(snd, 2); }
#pragma unroll
  for (int k = 0; k < 2; ++k) { int snd = b0 ? q4[k] : q4[k + 2]; int kp = b0 ? q4[k + 2] : q4[k]; q2[k] = kp + __shfl_xor(snd, 1); }
  int* ap = accw + i * 128 + g * 16 + 2 * c;
  ap[0] += q2[0];
  ap[1] += q2[1];
}
DI void gv_issue(const unsigned char* __restrict__ vb, const int* idw, int i, int j, int g, int c, u32x4 (&r)[16]) {
  i32x4 id[4];
#pragma unroll
  for (int q = 0; q < 4; ++q) id[q] = *(const i32x4*)(idw + i * 128 + g * 16 + 4 * q);
  const unsigned so = (unsigned)(j * (16384 * 128) + 16 * c);
#pragma unroll
  for (int b = 0; b < 16; ++b) r[b] = *(const u32x4*)(vb + (size_t)((unsigned)id[b >> 2][b & 3] + so));
}
DI void gv_compute(const Params& p, int layer, const float* accw, int tok, int i, int j, int g, int c, int lane, const u32x4 (&r)[16], bool dry) {
  char* ws = p.ws;
  const size_t oo = (size_t)tok * 1024 + 128 * j + 16 * c + 2 * g;
  const unsigned xin = *(const unsigned*)((const short*)(ws + OFF_XB) + oo);
  f2v o = {bflo(xin), bfhi(xin)};
  f32x4 wv[4];
#pragma unroll
  for (int q = 0; q < 4; ++q) wv[q] = *(const f32x4*)(accw + i * 128 + g * 16 + 4 * q);
  f2v y[8];
#pragma unroll
  for (int q = 0; q < 8; ++q) { y[q][0] = 0.f; y[q][1] = 0.f; }
#pragma unroll
  for (int b = 0; b < 16; ++b) {
    const float wk = wv[b >> 2][b & 3];
    const f2v wk2 = {wk, wk};
#pragma unroll
    for (int q = 0; q < 4; ++q) {
      y[2 * q] += wk2 * __builtin_amdgcn_cvt_pk_f32_fp8((int)r[b][q], false);
      y[2 * q + 1] += wk2 * __builtin_amdgcn_cvt_pk_f32_fp8((int)r[b][q], true);
    }
  }
  const bool b5 = lane & 32, b4 = lane & 16, b3 = lane & 8;
  f2v y4[4], y2[2], y1;
#pragma unroll
  for (int q = 0; q < 4; ++q) {
    f2v snd = b5 ? y[q] : y[q + 4], kp = b5 ? y[q + 4] : y[q];
    y4[q][0] = kp[0] + __shfl_xor(snd[0], 32); y4[q][1] = kp[1] + __shfl_xor(snd[1], 32);
  }
#pragma unroll
  for (int q = 0; q < 2; ++q) {
    f2v snd = b4 ? y4[q] : y4[q + 2], kp = b4 ? y4[q + 2] : y4[q];
    y2[q][0] = kp[0] + __shfl_xor(snd[0], 16); y2[q][1] = kp[1] + __shfl_xor(snd[1], 16);
  }
  {
    f2v snd = b3 ? y2[0] : y2[1], kp = b3 ? y2[1] : y2[0];
    y1[0] = kp[0] + __shfl_xor(snd[0], 8); y1[1] = kp[1] + __shfl_xor(snd[1], 8);
  }
  float* ss2 = (float*)(ws + OFF_SS) + 2 * T;
  if (dry) { if (y1[0] == 123.456f) ss2[tok] = y1[1] + o[0]; return; }
  o += y1;
  if (layer == 1) *(f2v*)(p.out + oo) = o;
  if (layer == 0) {
    *(unsigned*)((short*)(ws + OFF_XB) + oo) = pack2(o[0], o[1]);
    float sq = o[0] * o[0] + o[1] * o[1];
#pragma unroll
    for (int m = 32; m > 0; m >>= 1) sq += __shfl_xor(sq, m);
    if (lane == 0) unsafeAtomicAdd(ss2 + tok, sq);
  }
}

DI void phase_gather(const Params& p, int layer, char* lds, int bid, int nb, bool dry = false) {
  char* ws = p.ws;
  const int lane = lane_id(), wid = p.wv;
  const int gw = bid * NWAVE + wid, nw = nb * NWAVE;
  float* accw = (float*)lds + wid * 2048;
  int* idw = (int*)(lds + NWAVE * 8192) + wid * 2048;
  const int* idxb = (const int*)(ws + OFF_IDX);
  const float* gsv = (const float*)(ws + OFF_G);
  const float* suv = (const float*)(ws + OFF_SUV);
  const float* ssc = (const float*)(ws + OFF_SS) + (layer == 0 ? 1 : 3) * T;
  const unsigned char* ub = (const unsigned char*)(ws + OFF_UB) + (size_t)layer * 16384 * 1024;
  const unsigned char* vb = (const unsigned char*)(ws + OFF_VB) + (size_t)layer * 16384 * 1024;
  const unsigned char* x8 = (const unsigned char*)(ws + OFF_X8);
  const int g = lane >> 3, c = lane & 7;
  for (int base = 0; base + gw < T; base += 16 * nw) {
    int ntok = (T - base - gw + nw - 1) / nw;
    ntok = ntok > 16 ? 16 : ntok;
    if (ntok == 16) {
      int t0[16], t1[16];
      const unsigned eo0 = (unsigned)(base + gw) * 128u + (unsigned)lane, st = (unsigned)nw * 128u;
#pragma unroll
      for (int i = 0; i < 16; ++i) { t0[i] = idxb[eo0 + i * st]; t1[i] = idxb[eo0 + i * st + 64u]; }
#pragma unroll
      for (int i = 0; i < 16; ++i) {
        idw[i * 128 + lane] = t0[i] << 7; idw[i * 128 + 64 + lane] = t1[i] << 7;
        accw[i * 128 + lane] = 0.f; accw[i * 128 + 64 + lane] = 0.f;
      }
    } else {
      for (int i = 0; i < ntok; ++i) {
        const size_t eo = (size_t)(base + i * nw + gw) * 128 + lane;
        idw[i * 128 + lane] = idxb[eo] << 7; idw[i * 128 + 64 + lane] = idxb[eo + 64] << 7;
        accw[i * 128 + lane] = 0.f; accw[i * 128 + 64 + lane] = 0.f;
      }
    }
    const int nit = 8 * ntok;
    u32x4 rA[16], rB[16];
    for (int rep = 0; rep < (PROBE_GU ? 2 : 1); ++rep) {
      if (rep) for (int i = 0; i < ntok; ++i) { accw[i * 128 + lane] = 0.f; accw[i * 128 + 64 + lane] = 0.f; }
      u32x4 hA, hB;
      int ji = 0, ii = 0, ic = 0;
      gu_issue(ub, x8, idw, base + ii * nw + gw, ii, ji, g, c, rA, hA); if (++ii == ntok) { ii = 0; ++ji; }
      for (int it = 0; it < nit; it += 2) {
        if (it + 1 < nit) { gu_issue(ub, x8, idw, base + ii * nw + gw, ii, ji, g, c, rB, hB); if (++ii == ntok) { ii = 0; ++ji; } }
        gu_compute((int*)accw, ic, g, c, lane, rA, hA); if (++ic == ntok) ic = 0;
        if (it + 1 < nit) {
          if (it + 2 < nit) { gu_issue(ub, x8, idw, base + ii * nw + gw, ii, ji, g, c, rA, hA); if (++ii == ntok) { ii = 0; ++ji; } }
          gu_compute((int*)accw, ic, g, c, lane, rB, hB); if (++ic == ntok) ic = 0;
        }
      }
    }
    if (ntok == 16) {
      float su0[16], su1[16], gs0[16], gs1[16];
      const unsigned eo0 = (unsigned)(base + gw) * 128u + (unsigned)lane, st = (unsigned)nw * 128u;
#pragma unroll
      for (int i = 0; i < 16; ++i) { su0[i] = suv[eo0 + i * st]; su1[i] = suv[eo0 + i * st + 64u]; gs0[i] = gsv[eo0 + i * st]; gs1[i] = gsv[eo0 + i * st + 64u]; }
#pragma unroll
      for (int i = 0; i < 16; ++i) {
        const float a0 = (float)((const int*)accw)[i * 128 + lane] * su0[i] * (6.0f / 127.0f), a1 = (float)((const int*)accw)[i * 128 + 64 + lane] * su1[i] * (6.0f / 127.0f);
        accw[i * 128 + lane] = gs0[i] * 0.5f * a0 * (1.0f + erff(a0 * 0.70710678118654752f));
        accw[i * 128 + 64 + lane] = gs1[i] * 0.5f * a1 * (1.0f + erff(a1 * 0.70710678118654752f));
      }
    } else {
      for (int i = 0; i < ntok; ++i) {
        const size_t eo = (size_t)(base + i * nw + gw) * 128 + lane;
        const float a0 = (float)((const int*)accw)[i * 128 + lane] * suv[eo] * (6.0f / 127.0f), a1 = (float)((const int*)accw)[i * 128 + 64 + lane] * suv[eo + 64] * (6.0f / 127.0f);
        accw[i * 128 + lane] = gsv[eo] * 0.5f * a0 * (1.0f + erff(a0 * 0.70710678118654752f));
        accw[i * 128 + 64 + lane] = gsv[eo + 64] * 0.5f * a1 * (1.0f + erff(a1 * 0.70710678118654752f));
      }
    }
    for (int rep = 0; rep < (PROBE_GV ? 2 : 1); ++rep) {
      const bool dryv = dry || (PROBE_GV && rep == 0);
      int ji = 0, ii = 0, jc = 0, ic = 0;
      gv_issue(vb, idw, ii, ji, g, c, rA); if (++ii == ntok) { ii = 0; ++ji; }
      for (int it = 0; it < nit; it += 2) {
        if (it + 1 < nit) { gv_issue(vb, idw, ii, ji, g, c, rB); if (++ii == ntok) { ii = 0; ++ji; } }
        gv_compute(p, layer, accw, base + ic * nw + gw, ic, jc, g, c, lane, rA, dryv); if (++ic == ntok) { ic = 0; ++jc; }
        if (it + 1 < nit) {
          if (it + 2 < nit) { gv_issue(vb, idw, ii, ji, g, c, rA); if (++ii == ntok) { ii = 0; ++ji; } }
          gv_compute(p, layer, accw, base + ic * nw + gw, ic, jc, g, c, lane, rB, dryv); if (++ic == ntok) { ic = 0; ++jc; }
        }
      }
    }
  }
}

DI void phase_convmix(const Params& p, int bid, int nb, bool dry = false) {
  char* ws = p.ws;
  short* cb = (short*)(ws + OFF_CB);
  const short* cz = (const short*)(ws + OFF_CZ);
  const float* cw = p.conv_w;
  for (size_t i = (size_t)bid * NTHR + TIDX; i < (size_t)T * 128; i += (size_t)nb * NTHR) {
    const int tok = (int)(i >> 7), ch = (int)(i & 127) * 8, pos = tok & (SEQ - 1);
    const size_t off = (size_t)tok * 1024 + ch;
    u32x4 bv = *(const u32x4*)(cb + off);
    u32x4 z0 = *(const u32x4*)(cz + off);
    u32x4 z1 = {0, 0, 0, 0}, z2 = {0, 0, 0, 0};
    if (pos >= 1) z1 = *(const u32x4*)(cz + off - 1024);
    if (pos >= 2) z2 = *(const u32x4*)(cz + off - 2048);
    u32x4 o;
#pragma unroll
    for (int j = 0; j < 4; ++j) {
      const int c0 = ch + 2 * j, c1 = c0 + 1;
      float a0 = cw[c0] * bflo(z2[j]) + cw[1024 + c0] * bflo(z1[j]) + cw[2048 + c0] * bflo(z0[j]);
      float a1 = cw[c1] * bfhi(z2[j]) + cw[1024 + c1] * bfhi(z1[j]) + cw[2048 + c1] * bfhi(z0[j]);
      o[j] = pack2(a0 * bflo(bv[j]), a1 * bfhi(bv[j]));
    }
    if (!dry) *(u32x4*)(cb + off) = o;
  }
}

constexpr int N_PHASES = 13;

DI void grid_barrier(const Params& p, unsigned* bar, unsigned gen, int bid, int nb) {
  __syncthreads();
  int ln;
  asm volatile("v_mbcnt_lo_u32_b32 %0, -1, 0\n\tv_mbcnt_hi_u32_b32 %0, -1, %0" : "=v"(ln));
  if (p.wv == 0 && ln == 0) {
    __builtin_amdgcn_fence(__ATOMIC_RELEASE, "agent");
    constexpr int NG = 32;
    const int x = bid & (NG - 1);
    const unsigned gsz = (unsigned)((nb - x + NG - 1) / NG), ngroups = (unsigned)(nb < NG ? nb : NG);
    unsigned* cnt = bar + 16 * (1 + x);
    unsigned* rel = bar + 16 * (1 + NG + x);
    const unsigned old = __hip_atomic_fetch_add(cnt, 1u, __ATOMIC_RELAXED, __HIP_MEMORY_SCOPE_AGENT);
    if (old + 1u == gen * gsz) {
      __hip_atomic_fetch_add(bar, 1u, __ATOMIC_RELAXED, __HIP_MEMORY_SCOPE_AGENT);
      while (__hip_atomic_load(bar, __ATOMIC_RELAXED, __HIP_MEMORY_SCOPE_AGENT) < gen * ngroups) __builtin_amdgcn_s_sleep(8);
      __hip_atomic_store(rel, gen, __ATOMIC_RELAXED, __HIP_MEMORY_SCOPE_AGENT);
    } else {
      while (__hip_atomic_load(rel, __ATOMIC_RELAXED, __HIP_MEMORY_SCOPE_AGENT) < gen) __builtin_amdgcn_s_sleep(16);
    }
    __builtin_amdgcn_fence(__ATOMIC_ACQUIRE, "agent");
  }
  __syncthreads();
}

__global__ void __launch_bounds__(NTHR, 2) mk(Params p_in, int ph_lo, int ph_hi) {
  Params p = p_in;
  p.wv = __builtin_amdgcn_readfirstlane((int)(threadIdx.x >> 6));
  extern __shared__ __attribute__((aligned(16))) char lds[];
  cg::grid_group grid = cg::this_grid();
  const int bid = blockIdx.x, nb = gridDim.x;
  const int vb = ((nb & 7) == 0) ? ((bid & 7) * (nb >> 3) + (bid >> 3)) : bid;
  char* ws = p.ws;
  unsigned* bar = (unsigned*)(ws + OFF_BAR);
  unsigned gen = 0;
  if (ph_lo < 0) grid.sync();
#ifndef PROBE_DUP
#define PROBE_DUP 0
#endif
#define GSYNC grid_barrier(p, bar, ++gen, bid, nb)
#define PHASE(n, call, drycall) if (ph_lo <= (n) && (n) < ph_hi) { if ((PROBE_DUP >> (n)) & 1) { drycall; GSYNC; } call; if ((n) + 1 < ph_hi) GSYNC; }
  PHASE(0, phase_prep(p, lds, bid, nb), phase_prep(p, lds, bid, nb))
  PHASE(1, gemm_phase<EPI_QKV>(p, (const short*)(ws + OFF_WQKVT), (const short*)(ws + OFF_XB), 1536, lds, vb, nb, 0), gemm_phase<EPI_QKV>(p, (const short*)(ws + OFF_WQKVT), (const short*)(ws + OFF_XB), 1536, lds, vb, nb, 0, true, PROBE_GV2))
  PHASE(2, phase_attn(p, lds, bid, nb), phase_attn(p, lds, bid, nb))
  PHASE(3, gemm_phase<EPI_RES>(p, (const short*)(ws + OFF_WOT), (const short*)(ws + OFF_O), 1024, lds, vb, nb, 0), gemm_phase<EPI_RES>(p, (const short*)(ws + OFF_WOT), (const short*)(ws + OFF_O), 1024, lds, vb, nb, 0, true, PROBE_GV2))
  PHASE(4, gemm_phase<EPI_PQ>(p, (const short*)(ws + OFF_WQT), (const short*)(ws + OFF_XB), 2048, lds, vb, nb, 0), gemm_phase<EPI_PQ>(p, (const short*)(ws + OFF_WQT), (const short*)(ws + OFF_XB), 2048, lds, vb, nb, 0, true, PROBE_GV2))
  PHASE(5, phase_score(p, 0, lds, bid, nb), phase_score(p, 0, lds, bid, nb))
  PHASE(6, phase_gather(p, 0, lds, bid, nb), phase_gather(p, 0, lds, bid, nb, true))
  PHASE(7, gemm_phase<EPI_CONVIN>(p, (const short*)(ws + OFF_WINT), (const short*)(ws + OFF_XB), 3072, lds, vb, nb, 1), gemm_phase<EPI_CONVIN>(p, (const short*)(ws + OFF_WINT), (const short*)(ws + OFF_XB), 3072, lds, vb, nb, 1, true, PROBE_GV2))
  PHASE(8, phase_convmix(p, bid, nb), phase_convmix(p, bid, nb, true))
  PHASE(9, gemm_phase<EPI_RES>(p, (const short*)(ws + OFF_WOUTT), (const short*)(ws + OFF_CB), 1024, lds, vb, nb, 1), gemm_phase<EPI_RES>(p, (const short*)(ws + OFF_WOUTT), (const short*)(ws + OFF_CB), 1024, lds, vb, nb, 1, true, PROBE_GV2))
  PHASE(10, gemm_phase<EPI_PQ>(p, (const short*)(ws + OFF_WQT) + (size_t)2048 * 1024, (const short*)(ws + OFF_XB), 2048, lds, vb, nb, 1), gemm_phase<EPI_PQ>(p, (const short*)(ws + OFF_WQT) + (size_t)2048 * 1024, (const short*)(ws + OFF_XB), 2048, lds, vb, nb, 1, true, PROBE_GV2))
  PHASE(11, phase_score(p, 1, lds, bid, nb), phase_score(p, 1, lds, bid, nb))
  PHASE(12, phase_gather(p, 1, lds, bid, nb), phase_gather(p, 1, lds, bid, nb, true))
}

extern "C" void kernel_launch(void* const* d_in, const int* in_sizes, int n_in, void* d_out, int out_size, void* d_ws, size_t ws_size,
                              hipStream_t stream) {
  static int grid_blocks = 0;
  if (!grid_blocks) {
    hipFuncSetAttribute((const void*)mk, hipFuncAttributeMaxDynamicSharedMemorySize, LDS_BYTES);
    int dev = 0, cus = 0, per_cu = 0;
    hipGetDevice(&dev);
    hipDeviceGetAttribute(&cus, hipDeviceAttributeMultiprocessorCount, dev);
    hipOccupancyMaxActiveBlocksPerMultiprocessor(&per_cu, mk, NTHR, LDS_BYTES);
    if (per_cu > 1) per_cu = 1;
    if (per_cu < 1) per_cu = 1;
    grid_blocks = cus * per_cu;
  }
  Params p{};
  p.x = (const float*)d_in[0]; p.norm_mix = (const float*)d_in[1]; p.norm_ffn = (const float*)d_in[2]; p.w_qkv = (const float*)d_in[3];
  p.q_norm = (const float*)d_in[4]; p.k_norm = (const float*)d_in[5]; p.sinks = (const float*)d_in[6]; p.w_o = (const float*)d_in[7];
  p.w_in = (const float*)d_in[8]; p.conv_w = (const float*)d_in[9]; p.w_out = (const float*)d_in[10]; p.w_query = (const float*)d_in[11];
  p.sub_keys = (const float*)d_in[12]; p.peer_u = (const float*)d_in[13]; p.peer_v = (const float*)d_in[14];
  p.out = (float*)d_out; p.ws = (char*)d_ws;
  hipMemsetAsync((char*)d_ws + OFF_BAR, 0, 8192, stream);
#if MULTI_LAUNCH
  for (int ph = 0; ph < N_PHASES; ++ph) {
    hipLaunchKernelGGL(mk, dim3(grid_blocks), dim3(NTHR), LDS_BYTES, stream, p, ph, ph + 1);
  }
#else
  int lo = 0, hi = N_PHASES;
  void* args[] = {&p, &lo, &hi};
  hipError_t e = hipLaunchCooperativeKernel((const void*)mk, dim3(grid_blocks), dim3(NTHR), args, LDS_BYTES, stream);
  if (e != hipSuccess) fprintf(stderr, "cooperative launch failed: %s (grid %d)\n", hipGetErrorString(e), grid_blocks);
#endif
}
```

```cpp
#include <hip/hip_runtime.h>
#include <hip/hip_cooperative_groups.h>
#include <cstdio>
namespace cg = cooperative_groups;

#ifndef PROBE_GV2
#define PROBE_GV2 0
#endif
#ifndef PROBE_GU
#define PROBE_GU 0
#endif
#ifndef PROBE_GV
#define PROBE_GV 0
#endif
#ifndef MULTI_LAUNCH
#define MULTI_LAUNCH 0
#endif

typedef __attribute__((ext_vector_type(8))) short bf16x8;
typedef __attribute__((ext_vector_type(16))) float f32x16;
typedef __attribute__((ext_vector_type(4))) float f32x4;
typedef __attribute__((ext_vector_type(4))) unsigned u32x4;
typedef __attribute__((ext_vector_type(2))) unsigned u32x2;
typedef __attribute__((ext_vector_type(4))) int i32x4;
typedef __bf16 bf2_t __attribute__((ext_vector_type(2)));
typedef float f2_t __attribute__((ext_vector_type(2)));

#define DI __device__ __forceinline__
#define MFMA32(a, b, c) __builtin_amdgcn_mfma_f32_32x32x16_bf16((a), (b), (c), 0, 0, 0)

constexpr int T = 32768;
constexpr int SEQ = 4096;
constexpr float EPS = 1e-6f;

constexpr size_t OFF_WQKVT = 0;
constexpr size_t OFF_WOT   = OFF_WQKVT + (size_t)1536 * 1024 * 2;
constexpr size_t OFF_WINT  = OFF_WOT + (size_t)1024 * 1024 * 2;
constexpr size_t OFF_WOUTT = OFF_WINT + (size_t)3072 * 1024 * 2;
constexpr size_t OFF_WQT   = OFF_WOUTT + (size_t)1024 * 1024 * 2;
constexpr size_t OFF_KEYS  = OFF_WQT + (size_t)2 * 2048 * 1024 * 2;
constexpr size_t OFF_ROPE  = OFF_KEYS + (size_t)2 * 262144 * 2;
constexpr size_t OFF_SS    = OFF_ROPE + (size_t)4096 * 8 * 8;
constexpr size_t OFF_UB    = OFF_SS + (size_t)4 * T * 4;
constexpr size_t OFF_SU    = OFF_UB + (size_t)2 * 16384 * 1024;
constexpr size_t OFF_VB    = OFF_UB + (size_t)2 * 16384 * 1024 * 2;
constexpr size_t OFF_SV    = OFF_VB + (size_t)2 * 16384 * 1024;
constexpr size_t OFF_XB    = OFF_VB + (size_t)2 * 16384 * 1024 * 2;
constexpr size_t OFF_IDX   = OFF_XB + (size_t)T * 1024 * 2;
constexpr size_t OFF_G     = OFF_IDX + (size_t)T * 128 * 4;
constexpr size_t OFF_BIG   = OFF_G + (size_t)T * 128 * 4;
constexpr size_t OFF_Q     = OFF_BIG;
constexpr size_t OFF_K     = OFF_Q + (size_t)T * 1024 * 2;
constexpr size_t OFF_VT    = OFF_K + (size_t)T * 256 * 2;
constexpr size_t OFF_O     = OFF_VT + (size_t)T * 256 * 2;
constexpr size_t OFF_A     = OFF_O + (size_t)T * 1024 * 2;
constexpr size_t OFF_SUV   = OFF_A + (size_t)T * 128 * 4;
constexpr size_t OFF_X8    = OFF_SUV + (size_t)T * 128 * 4;
constexpr size_t OFF_BAR   = OFF_X8 + (size_t)T * 1024;
constexpr size_t OFF_PQ    = OFF_BIG;
constexpr size_t OFF_CB    = OFF_BIG;
constexpr size_t OFF_CZ    = OFF_CB + (size_t)T * 1024 * 2;

constexpr int NTHR = 512, NWAVE = 8;
constexpr int LDS_BYTES = 147456;
constexpr int LROW = 144;
constexpr int LSTAGE = 73728;
constexpr int LBOFF = 36864;

struct Params {
  const float* x; const float* norm_mix; const float* norm_ffn; const float* w_qkv; const float* q_norm; const float* k_norm;
  const float* sinks; const float* w_o; const float* w_in; const float* conv_w; const float* w_out; const float* w_query;
  const float* sub_keys; const float* peer_u; const float* peer_v;
  float* out; char* ws;
  int wv; int pad_;
};

DI unsigned pack2(float a, float b) { f2_t v = {a, b}; bf2_t r = __builtin_convertvector(v, bf2_t); return __builtin_bit_cast(unsigned, r); }
DI float bflo(unsigned u) { return __uint_as_float(u << 16); }
DI float bfhi(unsigned u) { return __uint_as_float(u & 0xffff0000u); }
DI int lane_id() { return (int)__builtin_amdgcn_mbcnt_hi(~0u, __builtin_amdgcn_mbcnt_lo(~0u, 0u)); }
#define TIDX (p.wv * 64 + lane_id())
DI int crow(int r, int half) { return (r & 3) + 8 * (r >> 2) + 4 * half; }

DI void transpose_job(const float* __restrict__ W, int N, short* __restrict__ Wt, const float* __restrict__ gain, bool winmap,
                      float* tlb, int bid, int nb, int tidx) {
  const int tid = tidx & 255, hb = tidx >> 8;
  float* tl = tlb + hb * (64 * 65);
  const int vbid = bid * 2 + hb, vnb = nb * 2;
  const int ntn = N >> 6;
  const int ntiles = ntn * 16;
  const int iters = (ntiles + vnb - 1) / vnb;
  for (int it = 0; it < iters; ++it) {
    const int tile = it * vnb + vbid;
    const bool act = tile < ntiles;
    const int tn = tile % ntn, tk = tile / ntn;
    const int v0 = tn << 6, k0 = tk << 6;
    __syncthreads();
    if (act) {
      const int j = tid & 63;
      int v = v0 + j, col = v;
      if (winmap && v >= 1024) {
        int w = v - 1024; int bz = w >> 7, i = w & 127; int wmm = i >> 6, mt = (i >> 5) & 1, rr = i & 31;
        col = (mt ? 2048 : 1024) + 64 * bz + 32 * wmm + rr;
      }
#pragma unroll
      for (int i = 0; i < 16; ++i) {
        int kk = (tid >> 6) + 4 * i;
        float val = W[(size_t)(k0 + kk) * N + col];
        if (gain) val *= gain[k0 + kk];
        tl[kk * 65 + j] = val;
      }
    }
    __syncthreads();
    if (act) {
#pragma unroll
      for (int c = 0; c < 2; ++c) {
        int chunk = tid + 256 * c;
        int n = chunk >> 3, kc = chunk & 7;
        u32x4 o;
        o[0] = pack2(tl[(kc * 8 + 0) * 65 + n], tl[(kc * 8 + 1) * 65 + n]);
        o[1] = pack2(tl[(kc * 8 + 2) * 65 + n], tl[(kc * 8 + 3) * 65 + n]);
        o[2] = pack2(tl[(kc * 8 + 4) * 65 + n], tl[(kc * 8 + 5) * 65 + n]);
        o[3] = pack2(tl[(kc * 8 + 6) * 65 + n], tl[(kc * 8 + 7) * 65 + n]);
        *(u32x4*)(Wt + (size_t)(v0 + n) * 1024 + k0 + kc * 8) = o;
      }
    }
  }
}

DI void convert_job(const float* __restrict__ src, short* __restrict__ dst, size_t n8, int bid, int nb, int tidx) {
  for (size_t i = (size_t)bid * NTHR + tidx; i < n8; i += (size_t)nb * NTHR) {
    f32x4 a = *(const f32x4*)(src + i * 8), b = *(const f32x4*)(src + i * 8 + 4);
    u32x4 o; o[0] = pack2(a[0], a[1]); o[1] = pack2(a[2], a[3]); o[2] = pack2(b[0], b[1]); o[3] = pack2(b[2], b[3]);
    *(u32x4*)(dst + i * 8) = o;
  }
}

typedef float f2v __attribute__((ext_vector_type(2)));
DI void fp8_job(const float* __restrict__ src, unsigned char* __restrict__ dst, float* __restrict__ scale, int nrows, const float* __restrict__ gain, int bid, int nb, int tidx) {
  const int lane = tidx & 63, gw = bid * NWAVE + (tidx >> 6), nw = nb * NWAVE;
  for (int row = gw; row < nrows; row += nw) {
    const float* rp = src + (size_t)row * 1024 + lane * 16;
    f32x4 a[4];
    float mx = 0.f;
#pragma unroll
    for (int j = 0; j < 4; ++j) { a[j] = *(const f32x4*)(rp + 4 * j); if (gain) a[j] *= *(const f32x4*)(gain + (row >> 14) * 1024 + lane * 16 + 4 * j); mx = fmaxf(mx, fmaxf(fmaxf(fabsf(a[j][0]), fabsf(a[j][1])), fmaxf(fabsf(a[j][2]), fabsf(a[j][3])))); }
#pragma unroll
    for (int m = 32; m > 0; m >>= 1) mx = fmaxf(mx, __shfl_xor(mx, m));
    mx = fmaxf(mx, 1e-30f);
    const float inv = 224.0f / mx;
    u32x4 o;
#pragma unroll
    for (int j = 0; j < 4; ++j) {
      int w = 0;
      w = __builtin_amdgcn_cvt_pk_fp8_f32(a[j][0] * inv, a[j][1] * inv, w, false);
      w = __builtin_amdgcn_cvt_pk_fp8_f32(a[j][2] * inv, a[j][3] * inv, w, true);
      o[j] = (unsigned)w;
    }
    *(u32x4*)(dst + (size_t)(row >> 14) * (16384 * 1024) + (size_t)(lane >> 3) * (16384 * 128) + (size_t)(row & 16383) * 128 + (lane & 7) * 16) = o;
    if (lane == 0) scale[row] = mx * (1.0f / 224.0f);
  }
}

DI void i8_job(const float* __restrict__ src, unsigned char* __restrict__ dst, float* __restrict__ scale, int nrows, const float* __restrict__ gain, int bid, int nb, int tidx) {
  const int lane = tidx & 63, gw = bid * NWAVE + (tidx >> 6), nw = nb * NWAVE;
  for (int row = gw; row < nrows; row += nw) {
    const float* rp = src + (size_t)row * 1024 + lane * 16;
    f32x4 a[4];
    float mx = 0.f;
#pragma unroll
    for (int j = 0; j < 4; ++j) { a[j] = *(const f32x4*)(rp + 4 * j); a[j] *= *(const f32x4*)(gain + (row >> 14) * 1024 + lane * 16 + 4 * j); mx = fmaxf(mx, fmaxf(fmaxf(fabsf(a[j][0]), fabsf(a[j][1])), fmaxf(fabsf(a[j][2]), fabsf(a[j][3])))); }
#pragma unroll
    for (int m = 32; m > 0; m >>= 1) mx = fmaxf(mx, __shfl_xor(mx, m));
    mx = fmaxf(mx, 1e-30f);
    const float inv = 127.0f / mx;
    u32x4 o;
#pragma unroll
    for (int j = 0; j < 4; ++j) {
      unsigned w = 0;
#pragma unroll
      for (int e = 0; e < 4; ++e) { int q = __float2int_rn(a[j][e] * inv); q = q > 127 ? 127 : (q < -127 ? -127 : q); w |= ((unsigned)q & 0xffu) << (8 * e); }
      o[j] = w;
    }
    *(u32x4*)(dst + (size_t)(row >> 14) * (16384 * 1024) + (size_t)(lane >> 3) * (16384 * 128) + (size_t)(row & 16383) * 128 + (lane & 7) * 16) = o;
    if (lane == 0) scale[row] = mx * (1.0f / 127.0f);
  }
}

DI void phase_prep(const Params& p, char* lds, int bid, int nb) {
  char* ws = p.ws;
  float* tl = (float*)lds;
  const int tidx = TIDX;
  transpose_job(p.w_qkv, 1536, (short*)(ws + OFF_WQKVT), p.norm_mix, false, tl, bid, nb, tidx);
  transpose_job(p.w_o, 1024, (short*)(ws + OFF_WOT), nullptr, false, tl, bid, nb, tidx);
  transpose_job(p.w_in, 3072, (short*)(ws + OFF_WINT), p.norm_mix + 1024, true, tl, bid, nb, tidx);
  transpose_job(p.w_out, 1024, (short*)(ws + OFF_WOUTT), nullptr, false, tl, bid, nb, tidx);
  transpose_job(p.w_query, 2048, (short*)(ws + OFF_WQT), p.norm_ffn, false, tl, bid, nb, tidx);
  transpose_job(p.w_query + (size_t)1024 * 2048, 2048, (short*)(ws + OFF_WQT) + (size_t)2048 * 1024, p.norm_ffn + 1024, false, tl, bid, nb, tidx);
  convert_job(p.sub_keys, (short*)(ws + OFF_KEYS), (size_t)2 * 262144 / 8, bid, nb, tidx);
  i8_job(p.peer_u, (unsigned char*)(ws + OFF_UB), (float*)(ws + OFF_SU), 2 * 16384, p.norm_ffn, bid, nb, tidx);
  fp8_job(p.peer_v, (unsigned char*)(ws + OFF_VB), (float*)(ws + OFF_SV), 2 * 16384, nullptr, bid, nb, tidx);
  float* ss = (float*)(ws + OFF_SS);
  for (int i = bid * NTHR + tidx; i < T; i += nb * NTHR) {
    ss[T + i] = 0.f; ss[2 * T + i] = 0.f; ss[3 * T + i] = 0.f;
    const int pos = i >> 3, d = i & 7;
    const float fr[8] = {1.0f, 0.19392274f, 0.03760603f, 0.0072926646f, 0.0014142136f, 0.0002742482f, 5.3182957e-05f, 1.0313385e-05f};
    float f = d == 0 ? fr[0] : d == 1 ? fr[1] : d == 2 ? fr[2] : d == 3 ? fr[3] : d == 4 ? fr[4] : d == 5 ? fr[5] : d == 6 ? fr[6] : fr[7];
    float ang = (float)pos * f;
    ((float2*)(ws + OFF_ROPE))[i] = make_float2((float)cos((double)ang), (float)sin((double)ang));
  }
  {
    const int lane = tidx & 63, gw = bid * NWAVE + (tidx >> 6), nw = nb * NWAVE;
    short* xb = (short*)(ws + OFF_XB);
    for (int tok = gw; tok < T; tok += nw) {
      const float* xr = p.x + (size_t)tok * 1024;
      float s = 0.f;
#pragma unroll
      for (int hh = 0; hh < 2; ++hh) {
        f32x4 a = *(const f32x4*)(xr + hh * 512 + lane * 8), b = *(const f32x4*)(xr + hh * 512 + lane * 8 + 4);
        s += a[0] * a[0] + a[1] * a[1] + a[2] * a[2] + a[3] * a[3] + b[0] * b[0] + b[1] * b[1] + b[2] * b[2] + b[3] * b[3];
        u32x4 o; o[0] = pack2(a[0], a[1]); o[1] = pack2(a[2], a[3]); o[2] = pack2(b[0], b[1]); o[3] = pack2(b[2], b[3]);
        *(u32x4*)(xb + (size_t)tok * 1024 + hh * 512 + lane * 8) = o;
      }
#pragma unroll
      for (int m = 32; m > 0; m >>= 1) s += __shfl_xor(s, m);
      if (lane == 0) ss[tok] = s;
    }
  }
}

enum { EPI_QKV = 0, EPI_RES = 1, EPI_PQ = 2, EPI_CONVIN = 3 };

template <int EPI, int SUB>
DI void epilogue(const Params& p, f32x16 (&acc)[4][2], int fb, int tb, int lane, int layer, bool dry) {
  char* ws = p.ws;
  const int l32 = lane & 31, half = lane >> 5;
  float* ss = (float*)(ws + OFF_SS);
  if (EPI == EPI_QKV) {
    const int hd = fb >> 6;
#pragma unroll
    for (int nt = 0; nt < 2; ++nt) {
      const int tok = tb + nt * 32 + l32, pos = tok & (SEQ - 1), bb = tok >> 12;
      const float rs0 = rsqrtf(ss[tok] * (1.0f / 1024.0f) + EPS);
      if (hd < 20) {
        float sq = 0.f;
#pragma unroll
        for (int mt = 0; mt < 2; ++mt)
#pragma unroll
          for (int r = 0; r < 16; ++r) { float v = acc[2 * SUB + mt][nt][r] * rs0; sq += v * v; }
        sq += __shfl_xor(sq, 32);
        const float rs = rsqrtf(sq * (1.0f / 64.0f) + EPS) * rs0;
        const float* gain = hd < 16 ? p.q_norm : p.k_norm;
        const float sc = hd < 16 ? 0.125f : 1.0f;
        float v[2][16];
#pragma unroll
        for (int mt = 0; mt < 2; ++mt)
#pragma unroll
          for (int r = 0; r < 16; ++r) v[mt][r] = acc[2 * SUB + mt][nt][r] * rs * gain[mt * 32 + crow(r, half)];
        const float2* rt = (const float2*)(ws + OFF_ROPE) + pos * 8 + 4 * half;
#pragma unroll
        for (int r = 0; r < 4; ++r) {
          float2 cs = rt[r];
          float x1 = v[0][r], x2 = v[0][r + 4];
          v[0][r] = x1 * cs.x - x2 * cs.y;
          v[0][r + 4] = x2 * cs.x + x1 * cs.y;
        }
        short* dst = hd < 16 ? (short*)(ws + OFF_Q) + (size_t)tok * 1024 + hd * 64 : (short*)(ws + OFF_K) + (size_t)tok * 256 + (hd - 16) * 64;
#pragma unroll
        for (int mt = 0; mt < 2; ++mt)
#pragma unroll
          for (int g4 = 0; g4 < 4; ++g4) {
            u32x2 o; o[0] = pack2(v[mt][4 * g4] * sc, v[mt][4 * g4 + 1] * sc); o[1] = pack2(v[mt][4 * g4 + 2] * sc, v[mt][4 * g4 + 3] * sc);
            *(u32x2*)(dst + mt * 32 + 8 * g4 + 4 * half) = o;
          }
      } else {
        const int hk = hd - 20;
        unsigned short* vt = (unsigned short*)(ws + OFF_VT) + ((size_t)(bb * 4 + hk) * 64) * SEQ + pos;
#pragma unroll
        for (int mt = 0; mt < 2; ++mt)
#pragma unroll
          for (int r = 0; r < 16; ++r) {
            const int d = mt * 32 + crow(r, half);
            vt[(size_t)d * SEQ] = (unsigned short)(pack2(acc[2 * SUB + mt][nt][r] * rs0, 0.f) & 0xffffu);
          }
      }
    }
  } else if (EPI == EPI_RES) {
    const float* resid = layer == 0 ? p.x : p.out;
    float* ssn = ss + (layer == 0 ? 1 : 3) * T;
    short* xb = (short*)(ws + OFF_XB);
#pragma unroll
    for (int nt = 0; nt < 2; ++nt) {
      const int tok = tb + nt * 32 + l32;
      float sq = 0.f;
#pragma unroll
      for (int mt = 0; mt < 2; ++mt)
#pragma unroll
        for (int g4 = 0; g4 < 4; ++g4) {
          const size_t off = (size_t)tok * 1024 + fb + mt * 32 + 8 * g4 + 4 * half;
          f32x4 r = *(const f32x4*)(resid + off);
          f32x4 o;
#pragma unroll
          for (int j = 0; j < 4; ++j) { o[j] = r[j] + acc[2 * SUB + mt][nt][4 * g4 + j]; sq += o[j] * o[j]; }
          if (!dry) *(f32x4*)(p.out + off) = o;
          u32x2 ob; ob[0] = pack2(o[0], o[1]); ob[1] = pack2(o[2], o[3]);
          *(u32x2*)(xb + off) = ob;
          { int w8 = 0; w8 = __builtin_amdgcn_cvt_pk_fp8_f32(o[0], o[1], w8, false); w8 = __builtin_amdgcn_cvt_pk_fp8_f32(o[2], o[3], w8, true); *(int*)(ws + OFF_X8 + off) = w8; }
        }
      sq += __shfl_xor(sq, 32);
      if (half == 0 && !dry) unsafeAtomicAdd(ssn + tok, sq);
    }
  } else if (EPI == EPI_PQ) {
    const float* ssc = ss + (layer == 0 ? 1 : 3) * T;
    short* pq = (short*)(ws + OFF_PQ);
#pragma unroll
    for (int nt = 0; nt < 2; ++nt) {
      const int tok = tb + nt * 32 + l32;
      const float rs = rsqrtf(ssc[tok] * (1.0f / 1024.0f) + EPS);
#pragma unroll
      for (int mt = 0; mt < 2; ++mt)
#pragma unroll
        for (int g4 = 0; g4 < 4; ++g4) {
          u32x2 o; o[0] = pack2(acc[2 * SUB + mt][nt][4 * g4] * rs, acc[2 * SUB + mt][nt][4 * g4 + 1] * rs);
          o[1] = pack2(acc[2 * SUB + mt][nt][4 * g4 + 2] * rs, acc[2 * SUB + mt][nt][4 * g4 + 3] * rs);
          *(u32x2*)(pq + (size_t)tok * 2048 + fb + mt * 32 + 8 * g4 + 4 * half) = o;
        }
    }
  } else {
    const float* ssc = ss + 2 * T;
#pragma unroll
    for (int nt = 0; nt < 2; ++nt) {
      const int tok = tb + nt * 32 + l32;
      const float rs = rsqrtf(ssc[tok] * (1.0f / 1024.0f) + EPS);
      if (fb < 1024) {
        short* cb = (short*)(ws + OFF_CB);
#pragma unroll
        for (int mt = 0; mt < 2; ++mt)
#pragma unroll
          for (int g4 = 0; g4 < 4; ++g4) {
            u32x2 o; o[0] = pack2(acc[2 * SUB + mt][nt][4 * g4] * rs, acc[2 * SUB + mt][nt][4 * g4 + 1] * rs);
            o[1] = pack2(acc[2 * SUB + mt][nt][4 * g4 + 2] * rs, acc[2 * SUB + mt][nt][4 * g4 + 3] * rs);
            *(u32x2*)(cb + (size_t)tok * 1024 + fb + mt * 32 + 8 * g4 + 4 * half) = o;
          }
      } else {
        const int w = fb - 1024;
        const int chb = (w >> 7) * 64 + ((w >> 6) & 1) * 32;
        short* cz = (short*)(ws + OFF_CZ);
        const float rs2 = rs * rs;
#pragma unroll
        for (int g4 = 0; g4 < 4; ++g4) {
          float z0 = acc[2 * SUB][nt][4 * g4] * acc[2 * SUB + 1][nt][4 * g4] * rs2, z1 = acc[2 * SUB][nt][4 * g4 + 1] * acc[2 * SUB + 1][nt][4 * g4 + 1] * rs2;
          float z2 = acc[2 * SUB][nt][4 * g4 + 2] * acc[2 * SUB + 1][nt][4 * g4 + 2] * rs2, z3 = acc[2 * SUB][nt][4 * g4 + 3] * acc[2 * SUB + 1][nt][4 * g4 + 3] * rs2;
          u32x2 o; o[0] = pack2(z0, z1); o[1] = pack2(z2, z3);
          *(u32x2*)(cz + (size_t)tok * 1024 + chb + 8 * g4 + 4 * half) = o;
        }
      }
    }
  }
}

typedef __attribute__((ext_vector_type(4))) float f32x4v;
constexpr int G_HT = 128 * 64;
DI int g_lds_byte(int r, int c) { int st = (r >> 4) * 2 + (c >> 5), rr = r & 15, cc = c & 31, ob = rr * 64 + cc * 2; return st * 1024 + (ob ^ (((ob >> 9) & 1) << 5)); }
DI void g_stage_rc(int b, int& R, int& C) { int st = b / 1024, sb = b % 1024, swz = sb ^ (((sb >> 9) & 1) << 5); R = (st >> 1) * 16 + swz / 64; C = (st & 1) * 32 + (swz % 64) / 2; }

template <int NM>
DI void wave_store_rows(char* lb, const u32x2 (&v)[2][4], int lane, short* dst, size_t pitch) {
  const int fr = lane & 15, fq = lane >> 4;
#pragma unroll
  for (int n = 0; n < 2; ++n)
#pragma unroll
    for (int m = 0; m < NM; ++m) *(u32x2*)(lb + (n * 16 + fr) * 144 + m * 32 + fq * 8) = v[n][m];
  constexpr int LPR = NM * 2, RPI = 64 / LPR;
  const int rsub = lane / LPR, ch = lane % LPR;
#pragma unroll
  for (int it = 0; it < 32 / RPI; ++it) {
    const int row = it * RPI + rsub;
    const u32x4 x = *(const u32x4*)(lb + row * 144 + ch * 16);
    *(u32x4*)(dst + (size_t)row * pitch + ch * 8) = x;
  }
}

DI void wave_store_pq(char* lb, const u32x2 (&v)[2][4], int lane, short* pq, int tbase, int fb) {
  const int fr = lane & 15, fq = lane >> 4;
#pragma unroll
  for (int n = 0; n < 2; ++n)
#pragma unroll
    for (int m = 0; m < 4; ++m) *(u32x2*)(lb + (n * 16 + fr) * 144 + m * 32 + fq * 8) = v[n][m];
  const int r = lane & 31, c2 = lane >> 5;
  short* dst = pq + ((size_t)(tbase >> 5) * 256 + (fb >> 3)) * 256 + r * 8;
#pragma unroll
  for (int it = 0; it < 4; ++it) {
    const int ch = it * 2 + c2;
    const u32x4 x = *(const u32x4*)(lb + r * 144 + ch * 16);
    *(u32x4*)(dst + (size_t)ch * 256) = x;
  }
}

template <int EPI>
DI void epilogue8(const Params& p, f32x4v (&acc)[2][2][4][2], char* lb, int fb0, int tb0, int lane, int layer, bool dry) {
  char* ws = p.ws;
  const int fr = lane & 15, fq = lane >> 4;
  float* ss = (float*)(ws + OFF_SS);
#pragma unroll
  for (int ai = 0; ai < 2; ++ai) {
    const int fb = fb0 + ai * 128;
#pragma unroll
    for (int bj = 0; bj < 2; ++bj) {
      const int tbase = tb0 + bj * 128;
      u32x2 ov[2][4];
      if (EPI == EPI_QKV) {
        const int hd = fb >> 6;
        if (hd < 20) {
#pragma unroll
          for (int n = 0; n < 2; ++n) {
            const int tok = tbase + n * 16 + fr, pos = tok & (SEQ - 1);
            const float rs0 = rsqrtf(ss[tok] * (1.0f / 1024.0f) + EPS);
            float sq = 0.f;
#pragma unroll
            for (int m = 0; m < 4; ++m)
#pragma unroll
              for (int j = 0; j < 4; ++j) { float v = acc[ai][bj][m][n][j] * rs0; sq += v * v; }
            sq += __shfl_xor(sq, 16);
            sq += __shfl_xor(sq, 32);
            const float rs = rsqrtf(sq * (1.0f / 64.0f) + EPS) * rs0;
            const float* gain = hd < 16 ? p.q_norm : p.k_norm;
            const float sc = hd < 16 ? 0.125f : 1.0f;
            const float2* rt = (const float2*)(ws + OFF_ROPE) + pos * 8 + 4 * (fq & 1);
#pragma unroll
            for (int m = 0; m < 4; ++m) {
              const f32x4 gv = *(const f32x4*)(gain + m * 16 + fq * 4);
              float v[4];
#pragma unroll
              for (int j = 0; j < 4; ++j) v[j] = acc[ai][bj][m][n][j] * rs * gv[j];
              if (m == 0) {
#pragma unroll
                for (int j = 0; j < 4; ++j) {
                  const float mine = v[j], other = __shfl_xor(mine, 32);
                  const float2 cs = rt[j];
                  v[j] = (fq < 2) ? (mine * cs.x - other * cs.y) : (mine * cs.x + other * cs.y);
                }
              }
              ov[n][m][0] = pack2(v[0] * sc, v[1] * sc); ov[n][m][1] = pack2(v[2] * sc, v[3] * sc);
            }
          }
          short* dst = hd < 16 ? (short*)(ws + OFF_Q) + (size_t)tbase * 1024 + hd * 64 : (short*)(ws + OFF_K) + (size_t)tbase * 256 + (hd - 16) * 64;
          wave_store_rows<4>(lb, ov, lane, dst, hd < 16 ? 1024 : 256);
        } else {
          const int hk = hd - 20;
#pragma unroll
          for (int n = 0; n < 2; ++n) {
            const int tok = tbase + n * 16 + fr;
            const float rs0 = rsqrtf(ss[tok] * (1.0f / 1024.0f) + EPS);
#pragma unroll
            for (int m = 0; m < 4; ++m)
#pragma unroll
              for (int j = 0; j < 4; ++j)
                *(unsigned short*)(lb + (m * 16 + fq * 4 + j) * 80 + (n * 16 + fr) * 2) = (unsigned short)(pack2(acc[ai][bj][m][n][j] * rs0, 0.f) & 0xffffu);
          }
          const int bb = tbase >> 12, pos0 = tbase & (SEQ - 1);
          unsigned short* vt = (unsigned short*)(ws + OFF_VT) + ((size_t)(bb * 4 + hk) * 64) * SEQ + pos0;
          const int rsub = lane >> 2, ch = lane & 3;
#pragma unroll
          for (int it = 0; it < 4; ++it) {
            const int d = it * 16 + rsub;
            const u32x4 x = *(const u32x4*)(lb + d * 80 + ch * 16);
            *(u32x4*)(vt + (size_t)d * SEQ + ch * 8) = x;
          }
        }
      } else if (EPI == EPI_RES) {
        float* ssn = ss + (layer == 0 ? 1 : 3) * T;
        const short* xbr = (const short*)(ws + OFF_XB);
#pragma unroll
        for (int n = 0; n < 2; ++n) {
          const int tok = tbase + n * 16 + fr;
          float sq = 0.f;
#pragma unroll
          for (int m = 0; m < 4; ++m) {
            const size_t off = (size_t)tok * 1024 + fb + m * 16 + fq * 4;
            f32x4 r;
            { const u32x2 rb = *(const u32x2*)(xbr + off); r[0] = bflo(rb[0]); r[1] = bfhi(rb[0]); r[2] = bflo(rb[1]); r[3] = bfhi(rb[1]); }
            f32x4 o;
#pragma unroll
            for (int j = 0; j < 4; ++j) { o[j] = r[j] + acc[ai][bj][m][n][j]; sq += o[j] * o[j]; }
            ov[n][m][0] = pack2(o[0], o[1]); ov[n][m][1] = pack2(o[2], o[3]);
          }
          sq += __shfl_xor(sq, 16);
          sq += __shfl_xor(sq, 32);
          if (fq == 0 && !dry) unsafeAtomicAdd(ssn + tok, sq);
        }
        if (!dry) wave_store_rows<4>(lb, ov, lane, (short*)(ws + OFF_XB) + (size_t)tbase * 1024 + fb, 1024);
      } else if (EPI == EPI_PQ) {
        const float* ssc = ss + (layer == 0 ? 1 : 3) * T;
#pragma unroll
        for (int n = 0; n < 2; ++n) {
          const int tok = tbase + n * 16 + fr;
          const float rs = rsqrtf(ssc[tok] * (1.0f / 1024.0f) + EPS);
#pragma unroll
          for (int m = 0; m < 4; ++m) {
            ov[n][m][0] = pack2(acc[ai][bj][m][n][0] * rs, acc[ai][bj][m][n][1] * rs);
            ov[n][m][1] = pack2(acc[ai][bj][m][n][2] * rs, acc[ai][bj][m][n][3] * rs);
          }
        }
        wave_store_pq(lb, ov, lane, (short*)(ws + OFF_PQ), tbase, fb);
      } else {
        const bool isb = fb < 1024;
#pragma unroll
        for (int n = 0; n < 2; ++n) {
          const int tok = tbase + n * 16 + fr;
          const float rs = rsqrtf(ss[2 * T + tok] * (1.0f / 1024.0f) + EPS);
          if (isb) {
#pragma unroll
            for (int m = 0; m < 4; ++m) {
              ov[n][m][0] = pack2(acc[ai][bj][m][n][0] * rs, acc[ai][bj][m][n][1] * rs);
              ov[n][m][1] = pack2(acc[ai][bj][m][n][2] * rs, acc[ai][bj][m][n][3] * rs);
            }
          } else {
            const float rs2 = rs * rs;
#pragma unroll
            for (int m = 0; m < 2; ++m) {
              ov[n][m][0] = pack2(acc[ai][bj][m][n][0] * acc[ai][bj][m + 2][n][0] * rs2, acc[ai][bj][m][n][1] * acc[ai][bj][m + 2][n][1] * rs2);
              ov[n][m][1] = pack2(acc[ai][bj][m][n][2] * acc[ai][bj][m + 2][n][2] * rs2, acc[ai][bj][m][n][3] * acc[ai][bj][m + 2][n][3] * rs2);
              ov[n][m + 2][0] = 0; ov[n][m + 2][1] = 0;
            }
          }
        }
        if (isb) wave_store_rows<4>(lb, ov, lane, (short*)(ws + OFF_CB) + (size_t)tbase * 1024 + fb, 1024);
        else {
          const int w = fb - 1024;
          const int chb = (w >> 7) * 64 + ((w >> 6) & 1) * 32;
          wave_store_rows<2>(lb, ov, lane, (short*)(ws + OFF_CZ) + (size_t)tbase * 1024 + chb, 1024);
        }
      }
    }
  }
}

template <int EPI>
DI void gemm_phase(const Params& p, const short* __restrict__ A, const short* __restrict__ Bt, int Mfeat, char* lds, int vb, int nb, int layer, bool dry = false, int variant = 0) {
  short* shm = (short*)lds;
  constexpr int K = 1024, BK = 64, HALF = 128, nt = K / BK;
#define SA(b, h) (shm + ((b) * 2 + (h)) * G_HT)
#define SB_(b, h) (shm + (4 + (b) * 2 + (h)) * G_HT)
#define STAGE(P, BASE, br, kt) do { const unsigned _o = soff + (unsigned)(((br) * K + (kt) * BK) * 2); \
    __builtin_amdgcn_global_load_lds((const unsigned*)((const char*)(BASE) + (size_t)_o), (unsigned*)((char*)(P) + tidx * 16), 16, 0, 0); \
    __builtin_amdgcn_global_load_lds((const unsigned*)((const char*)(BASE) + (size_t)(_o + 64u * K * 2u)), (unsigned*)((char*)(P) + tidx * 16 + 8192), 16, 0, 0); } while (0)
#define LDA(dst, b, h) _Pragma("unroll") for (int m = 0; m < 4; ++m) _Pragma("unroll") for (int k = 0; k < 2; ++k) \
    dst[m][k] = *reinterpret_cast<const bf16x8*>((char*)SA(b, h) + g_lds_byte(wr * 64 + m * 16 + fr, k * 32 + fq * 8))
#define LDB(dst, b, h) _Pragma("unroll") for (int n = 0; n < 2; ++n) _Pragma("unroll") for (int k = 0; k < 2; ++k) \
    dst[n][k] = *reinterpret_cast<const bf16x8*>((char*)SB_(b, h) + g_lds_byte(wc * 32 + n * 16 + fr, k * 32 + fq * 8))
#define MMA(ai, bj, At_, Bt_) do { __builtin_amdgcn_s_setprio(1); \
    _Pragma("unroll") for (int m = 0; m < 4; ++m) _Pragma("unroll") for (int n = 0; n < 2; ++n) _Pragma("unroll") for (int k = 0; k < 2; ++k) \
      acc[ai][bj][m][n] = __builtin_amdgcn_mfma_f32_16x16x32_bf16(At_[m][k], Bt_[n][k], acc[ai][bj][m][n], 0, 0, 0); \
    __builtin_amdgcn_s_setprio(0); } while (0)
#define WAIT_V(n) asm volatile("s_waitcnt vmcnt(" #n ")" ::: "memory")
#define WAIT_L(n) asm volatile("s_waitcnt lgkmcnt(" #n ")" ::: "memory")
#define BAR __builtin_amdgcn_s_barrier()
#define SCHED __builtin_amdgcn_sched_barrier(0)
  const int tidx = TIDX;
  const int wid = tidx >> 6, lane = tidx & 63, wr = wid >> 2, wc = wid & 3, fr = lane & 15, fq = lane >> 4;
  int sR, sC;
  g_stage_rc(tidx * 16, sR, sC);
  const unsigned soff = (unsigned)(sR * K + sC) * 2u;
  const int mtiles = Mfeat >> 8;
  const int ntiles = mtiles * (T / 256);
  for (int tile = vb; tile < ntiles; tile += nb) {
    const int tm = tile % mtiles, tn = tile / mtiles;
    const int brow = tm << 8, bcol = tn << 8;
    f32x4v acc[2][2][4][2];
#pragma unroll
    for (int a = 0; a < 2; ++a)
#pragma unroll
      for (int b = 0; b < 2; ++b)
#pragma unroll
        for (int m = 0; m < 4; ++m)
#pragma unroll
          for (int n = 0; n < 2; ++n) acc[a][b][m][n] = f32x4v{0.f, 0.f, 0.f, 0.f};
    bf16x8 At[4][2], B0[2][2], B1[2][2];
    STAGE(SB_(0, 0), Bt, bcol, 0); STAGE(SA(0, 0), A, brow, 0);
    STAGE(SB_(0, 1), Bt, bcol + HALF, 0); STAGE(SA(0, 1), A, brow + HALF, 0);
    if (wr == 1) BAR;
    WAIT_V(4); BAR;
    STAGE(SB_(1, 0), Bt, bcol, 1); STAGE(SA(1, 0), A, brow, 1); STAGE(SB_(1, 1), Bt, bcol + HALF, 1);
    WAIT_V(6); BAR;
    for (int t = 0; t < nt - 2; t += 2) {
      LDB(B0, 0, 0); SCHED; LDA(At, 0, 0); STAGE(SA(1, 1), A, brow + HALF, t + 1);
      WAIT_L(8); BAR; WAIT_L(0); MMA(0, 0, At, B0); BAR; SCHED;
      LDB(B1, 0, 1); STAGE(SB_(0, 0), Bt, bcol, t + 2);
      BAR; WAIT_L(0); MMA(0, 1, At, B1); BAR;
      LDA(At, 0, 1); STAGE(SA(0, 0), A, brow, t + 2);
      BAR; WAIT_L(0); MMA(1, 0, At, B0); BAR; SCHED;
      STAGE(SB_(0, 1), Bt, bcol + HALF, t + 2);
      WAIT_V(6); BAR; MMA(1, 1, At, B1); BAR;
      LDB(B0, 1, 0); SCHED; LDA(At, 1, 0); STAGE(SA(0, 1), A, brow + HALF, t + 2);
      WAIT_L(8); BAR; WAIT_L(0); MMA(0, 0, At, B0); BAR; SCHED;
      LDB(B1, 1, 1); STAGE(SB_(1, 0), Bt, bcol, t + 3);
      BAR; WAIT_L(0); MMA(0, 1, At, B1); BAR;
      LDA(At, 1, 1); STAGE(SA(1, 0), A, brow, t + 3);
      BAR; WAIT_L(0); MMA(1, 0, At, B0); BAR; SCHED;
      STAGE(SB_(1, 1), Bt, bcol + HALF, t + 3);
      WAIT_V(6); BAR; MMA(1, 1, At, B1); BAR;
    }
    { LDB(B0, 0, 0); LDA(At, 0, 0); STAGE(SA(1, 1), A, brow + HALF, nt - 1);
      BAR; WAIT_L(0); MMA(0, 0, At, B0); BAR;
      LDB(B1, 0, 1); BAR; WAIT_L(0); MMA(0, 1, At, B1); BAR;
      LDA(At, 0, 1); WAIT_V(4); BAR; WAIT_L(0); MMA(1, 0, At, B0); MMA(1, 1, At, B1); BAR; }
    { LDB(B0, 1, 0); LDA(At, 1, 0); WAIT_V(2); BAR; WAIT_L(0); MMA(0, 0, At, B0); BAR;
      LDB(B1, 1, 1); WAIT_V(0); BAR; WAIT_L(0); MMA(0, 1, At, B1); BAR;
      LDA(At, 1, 1); BAR; WAIT_L(0); MMA(1, 0, At, B0); MMA(1, 1, At, B1); BAR; }
    if (wr == 0) BAR;
    __builtin_amdgcn_sched_barrier(0);
    epilogue8<EPI>(p, acc, lds + wid * 5120, brow + wr * 64, bcol + wc * 32, lane, layer, dry);
    WAIT_V(0);
    __syncthreads();
  }
  __syncthreads();
}

constexpr int AK_PITCH = 144;
constexpr int AV_PITCH = 528;
constexpr int AV_OFF = 256 * AK_PITCH;
DI void phase_attn(const Params& p, char* lds, int bid, int nb) {
  char* ws = p.ws;
  const int lane = lane_id(), wid = p.wv, l32 = lane & 31, half = lane >> 5;
  const int tidx = wid * 64 + lane;
  const short* qbuf = (const short*)(ws + OFF_Q);
  const short* kbuf = (const short*)(ws + OFF_K);
  const short* vtb = (const short*)(ws + OFF_VT);
  short* obuf = (short*)(ws + OFF_O);
  for (int blk = bid; blk < 1024; blk += nb) {
    const int hkv = blk & 3, n = (blk >> 2) & 31, b = blk >> 7;
    const int kbase = n * 128 - 128;
    __syncthreads();
#pragma unroll
    for (int i = 0; i < 4; ++i) {
      const int id = tidx + NTHR * i;
      const int key = id >> 3, ch = id & 7;
      if (kbase + key >= 0) *(u32x4*)(lds + key * AK_PITCH + ch * 16) = *(const u32x4*)(kbuf + (size_t)(b * SEQ + kbase + key) * 256 + hkv * 64 + ch * 8);
      const int d = id >> 5, vc = id & 31;
      if (kbase + vc * 8 >= 0) *(u32x4*)(lds + AV_OFF + d * AV_PITCH + vc * 16) = *(const u32x4*)(vtb + ((size_t)(b * 4 + hkv) * 64 + d) * SEQ + kbase + vc * 8);
    }
    __syncthreads();
    const int head = hkv * 4 + (wid & 3);
    const float sink = p.sinks[head];
#pragma unroll 1
    for (int cc = 0; cc < 2; ++cc) {
      const int c = (wid >> 2) * 2 + cc;
      const int qtok = b * SEQ + n * 128 + c * 32 + l32;
      bf16x8 qf[4];
#pragma unroll
      for (int ks = 0; ks < 4; ++ks) qf[ks] = *(const bf16x8*)(qbuf + (size_t)qtok * 1024 + head * 64 + ks * 16 + half * 8);
      f32x16 s[5];
      const int jt0 = (n == 0) ? (4 - c) : 0;
#pragma unroll
      for (int jt = 0; jt < 5; ++jt) {
#pragma unroll
        for (int r = 0; r < 16; ++r) s[jt][r] = 0.f;
        if (jt >= jt0) {
          const char* kp = lds + (32 * (c + jt) + l32) * AK_PITCH + half * 16;
#pragma unroll
          for (int ks = 0; ks < 4; ++ks) {
            bf16x8 kf = *(const bf16x8*)(kp + ks * 32);
            s[jt] = MFMA32(kf, qf[ks], s[jt]);
          }
        }
      }
      float m = sink;
#pragma unroll
      for (int jt = 0; jt < 5; ++jt)
#pragma unroll
        for (int r = 0; r < 16; ++r) {
          const int kr = crow(r, half);
          bool valid = jt >= jt0;
          if (jt == 0) valid = valid && (kr > l32);
          if (jt == 4) valid = valid && (kr <= l32);
          float v = valid ? s[jt][r] : -1e30f;
          s[jt][r] = v;
          m = fmaxf(m, v);
        }
      m = fmaxf(m, __shfl_xor(m, 32));
      float sum = 0.f;
#pragma unroll
      for (int jt = 0; jt < 5; ++jt)
#pragma unroll
        for (int r = 0; r < 16; ++r) { float e = __expf(s[jt][r] - m); s[jt][r] = e; sum += e; }
      sum += __shfl_xor(sum, 32);
      const float inv = 1.0f / (sum + __expf(sink - m));
      f32x16 o[2];
#pragma unroll
      for (int dt = 0; dt < 2; ++dt)
#pragma unroll
        for (int r = 0; r < 16; ++r) o[dt][r] = 0.f;
#pragma unroll
      for (int jt = 0; jt < 5; ++jt) {
        if (jt >= jt0) {
#pragma unroll
          for (int s2 = 0; s2 < 2; ++s2) {
            u32x4 pf;
            pf[0] = pack2(s[jt][8 * s2 + 0], s[jt][8 * s2 + 1]); pf[1] = pack2(s[jt][8 * s2 + 2], s[jt][8 * s2 + 3]);
            pf[2] = pack2(s[jt][8 * s2 + 4], s[jt][8 * s2 + 5]); pf[3] = pack2(s[jt][8 * s2 + 6], s[jt][8 * s2 + 7]);
            bf16x8 pb = __builtin_bit_cast(bf16x8, pf);
#pragma unroll
            for (int dt = 0; dt < 2; ++dt) {
              const char* vp = lds + AV_OFF + (dt * 32 + l32) * AV_PITCH + (32 * (c + jt) + 16 * s2 + 4 * half) * 2;
              u32x2 v0 = *(const u32x2*)(vp), v1 = *(const u32x2*)(vp + 16);
              u32x4 vf; vf[0] = v0[0]; vf[1] = v0[1]; vf[2] = v1[0]; vf[3] = v1[1];
              o[dt] = MFMA32(__builtin_bit_cast(bf16x8, vf), pb, o[dt]);
            }
          }
        }
      }
#pragma unroll
      for (int dt = 0; dt < 2; ++dt)
#pragma unroll
        for (int g4 = 0; g4 < 4; ++g4) {
          u32x2 ob; ob[0] = pack2(o[dt][4 * g4] * inv, o[dt][4 * g4 + 1] * inv); ob[1] = pack2(o[dt][4 * g4 + 2] * inv, o[dt][4 * g4 + 3] * inv);
          *(u32x2*)(obuf + (size_t)qtok * 1024 + head * 64 + dt * 32 + 8 * g4 + 4 * half) = ob;
        }
    }
  }
}

DI int f2key(float f) { int i = __float_as_int(f); return i ^ ((i >> 31) & 0x7fffffff); }
DI float key2f(int k) { return __int_as_float(k ^ ((k >> 31) & 0x7fffffff)); }
#define CEX(a, b) { int _hi = max((a), (b)); int _lo = min((a), (b)); (a) = _hi; (b) = _lo; }

DI void merge16_desc(int (&v)[16]) {
#pragma unroll
  for (int j = 8; j > 0; j >>= 1)
#pragma unroll
    for (int i = 0; i < 16; ++i) { const int l = i ^ j; if (l > i) CEX(v[i], v[l]); }
}
DI void sort16_desc(int (&v)[16]) {
#pragma unroll
  for (int k = 2; k <= 16; k <<= 1)
#pragma unroll
    for (int j = k >> 1; j > 0; j >>= 1)
#pragma unroll
      for (int i = 0; i < 16; ++i) {
        const int l = i ^ j;
        if (l > i) { if ((i & k) == 0) CEX(v[i], v[l]) else CEX(v[l], v[i]); }
      }
}
constexpr unsigned char CAND_I[50] = {0,0,0,0,0,0,0,0,0,0,0,0,0,0,0,0,1,1,1,1,1,1,1,1,2,2,2,2,2,3,3,3,3,4,4,4,5,5,6,6,7,7,8,9,10,11,12,13,14,15};
constexpr unsigned char CAND_J[50] = {0,1,2,3,4,5,6,7,8,9,10,11,12,13,14,15,0,1,2,3,4,5,6,7,0,1,2,3,4,0,1,2,3,0,1,2,0,1,0,1,0,1,0,0,0,0,0,0,0,0};
DI void sort32_desc(int (&v)[32]) {
#pragma unroll
  for (int k = 2; k <= 32; k <<= 1)
#pragma unroll
    for (int j = k >> 1; j > 0; j >>= 1)
#pragma unroll
      for (int i = 0; i < 32; ++i) {
        const int l = i ^ j;
        if (l > i) { if ((i & k) == 0) CEX(v[i], v[l]) else CEX(v[l], v[i]); }
      }
}
DI void topmerge(int (&a)[16], const int (&b)[16]) {
#pragma unroll
  for (int i = 0; i < 16; ++i) a[i] = max(a[i], b[15 - i]);
  merge16_desc(a);
}
DI int sel16(const int (&L)[16], int i) {
  int r = L[0];
#pragma unroll
  for (int q = 1; q < 16; ++q) r = (i == q) ? L[q] : r;
  return r;
}

DI void score_half(const short* __restrict__ pq, const char* klds, int tok, int h, int ph, int l32, int half, int (&top)[16]) {
  bf16x8 qf[8];
#pragma unroll
  for (int ks = 0; ks < 8; ++ks) qf[ks] = *(const bf16x8*)(pq + ((size_t)(tok >> 5) * 256 + (h * 32 + ph * 16 + ks * 2 + half)) * 256 + (tok & 31) * 8);
  const char* kb = klds + l32 * 272 + half * 16;
#pragma unroll 1
  for (int kt = 0; kt < 4; ++kt) {
    f32x16 acc;
#pragma unroll
    for (int r = 0; r < 16; ++r) acc[r] = 0.f;
#pragma unroll
    for (int ks = 0; ks < 8; ++ks) {
      bf16x8 kf = *(const bf16x8*)(kb + kt * 32 * 272 + ks * 32);
      acc = MFMA32(kf, qf[ks], acc);
    }
    int t2[16];
#pragma unroll
    for (int r = 0; r < 16; ++r) t2[r] = (f2key(acc[r]) & ~127) | (kt * 32 + crow(r, half));
    sort16_desc(t2);
    if (kt == 0) {
#pragma unroll
      for (int r = 0; r < 16; ++r) top[r] = t2[r];
    } else topmerge(top, t2);
  }
  int t3[16];
#pragma unroll
  for (int r = 0; r < 16; ++r) t3[r] = __shfl_xor(top[r], 32);
  topmerge(top, t3);
}

DI void phase_score(const Params& p, int layer, char* lds, int bid, int nb) {
  char* ws = p.ws;
  const int lane = lane_id(), wid = p.wv, l32 = lane & 31, half = lane >> 5;
  const short* pq = (const short*)(ws + OFF_PQ);
  const short* keys = (const short*)(ws + OFF_KEYS) + (size_t)layer * 262144;
  int* idxo = (int*)(ws + OFF_IDX);
  float* go = (float*)(ws + OFF_G);
  char* klds = lds + NWAVE * 8192;
  const int tidx = wid * 64 + lane;
  constexpr int KT_BYTES = 128 * 272;
  int hst = -1;
  for (int blk = bid; blk < 8192 / NWAVE; blk += nb) {
    const int h = blk & 7, tt = (blk >> 3) * NWAVE + wid;
    const int tok = tt * 32 + l32;
    {
      const float* ssq = (const float*)(ws + OFF_SS) + (layer == 0 ? 1 : 3) * T;
      const float qs = rsqrtf(ssq[tok] * (1.0f / 1024.0f) + EPS) * (127.0f / 6.0f);
      const short* xr = (const short*)(ws + OFF_XB) + (size_t)tok * 1024 + h * 128 + half * 64;
      unsigned char* xo = (unsigned char*)(ws + OFF_X8) + (size_t)tok * 1024 + h * 128 + half * 64;
#pragma unroll
      for (int q4 = 0; q4 < 4; ++q4) {
        u32x4 xa = *(const u32x4*)(xr + q4 * 16), xc = *(const u32x4*)(xr + q4 * 16 + 8);
        u32x4 o;
#pragma unroll
        for (int d = 0; d < 4; ++d) {
          const unsigned w0 = d < 2 ? xa[2 * d] : xc[2 * d - 4], w1 = d < 2 ? xa[2 * d + 1] : xc[2 * d - 3];
          const float f0 = __builtin_amdgcn_fmed3f(bflo(w0) * qs, -127.f, 127.f) + 12582912.0f, f1 = __builtin_amdgcn_fmed3f(bfhi(w0) * qs, -127.f, 127.f) + 12582912.0f;
          const float f2 = __builtin_amdgcn_fmed3f(bflo(w1) * qs, -127.f, 127.f) + 12582912.0f, f3 = __builtin_amdgcn_fmed3f(bfhi(w1) * qs, -127.f, 127.f) + 12582912.0f;
          o[d] = (__float_as_uint(f0) & 0xffu) | ((__float_as_uint(f1) & 0xffu) << 8) | ((__float_as_uint(f2) & 0xffu) << 16) | (__float_as_uint(f3) << 24);
        }
        *(u32x4*)(xo + q4 * 16) = o;
      }
    }
    if (h != hst) {
      __syncthreads();
#pragma unroll
      for (int i = 0; i < 8; ++i) {
        const int id = tidx + NTHR * i;
        *(u32x4*)(klds + (id >> 11) * KT_BYTES + ((id >> 4) & 127) * 272 + (id & 15) * 16) = *(const u32x4*)(keys + (size_t)h * 32768 + (size_t)(id >> 4) * 128 + (id & 15) * 8);
      }
      __syncthreads();
      hst = h;
    }
    int L0[16], L1[16];
    score_half(pq, klds, tok, h, 0, l32, half, L0);
    score_half(pq, klds + KT_BYTES, tok, h, 1, l32, half, L1);
    float v1[16], v2[16];
#pragma unroll
    for (int r = 0; r < 16; ++r) { v1[r] = key2f(L0[r] & ~127); v2[r] = key2f(L1[r] & ~127); }
    int cand[32];
#pragma unroll
    for (int sI = 0; sI < 25; ++sI) {
      const float va = v1[CAND_I[2 * sI]] + v2[CAND_J[2 * sI]], vb2 = v1[CAND_I[2 * sI + 1]] + v2[CAND_J[2 * sI + 1]];
      const int ca = CAND_I[2 * sI] * 16 + CAND_J[2 * sI], cb = CAND_I[2 * sI + 1] * 16 + CAND_J[2 * sI + 1];
      cand[sI] = (f2key(half ? vb2 : va) & ~255) | (half ? cb : ca);
    }
#pragma unroll
    for (int sI = 25; sI < 32; ++sI) cand[sI] = (int)0x80000000;
    sort32_desc(cand);
    int best[16], bo[16];
#pragma unroll
    for (int r = 0; r < 16; ++r) { best[r] = cand[r]; bo[r] = __shfl_xor(cand[r], 32); }
    topmerge(best, bo);
    int* lw = (int*)lds + wid * 2048 + lane;
#pragma unroll
    for (int r = 0; r < 16; ++r) { lw[r * 64] = L0[r] & 127; lw[(16 + r) * 64] = L1[r] & 127; }
    float sv[16]; int eid[16];
#pragma unroll
    for (int q = 0; q < 16; ++q) {
      const int code = best[q] & 255;
      sv[q] = key2f(best[q] & ~255);
      const int e1 = lw[(code >> 4) * 64], e2 = lw[(16 + (code & 15)) * 64];
      eid[q] = e1 * 128 + e2;
    }
    float sum = 0.f;
    const float mx = sv[0];
#pragma unroll
    for (int q = 0; q < 16; ++q) { sv[q] = __expf(sv[q] - mx); sum += sv[q]; }
    const float inv = 1.0f / sum;
    const size_t ob = ((size_t)tok * 8 + h) * 16;
    const float* sut = (const float*)(ws + OFF_SU) + layer * 16384;
    const float* svt = (const float*)(ws + OFF_SV) + layer * 16384;
    float* suo = (float*)(ws + OFF_SUV);
    if (half == 0) {
#pragma unroll
      for (int q4 = 0; q4 < 4; ++q4) {
        i32x4 o = {eid[4 * q4], eid[4 * q4 + 1], eid[4 * q4 + 2], eid[4 * q4 + 3]}; *(i32x4*)(idxo + ob + 4 * q4) = o;
        f32x4 o2 = {sut[eid[4 * q4]], sut[eid[4 * q4 + 1]], sut[eid[4 * q4 + 2]], sut[eid[4 * q4 + 3]]}; *(f32x4*)(suo + ob + 4 * q4) = o2;
      }
    } else {
#pragma unroll
      for (int q4 = 0; q4 < 4; ++q4) {
        f32x4 o = {sv[4 * q4] * inv * svt[eid[4 * q4]], sv[4 * q4 + 1] * inv * svt[eid[4 * q4 + 1]], sv[4 * q4 + 2] * inv * svt[eid[4 * q4 + 2]], sv[4 * q4 + 3] * inv * svt[eid[4 * q4 + 3]]};
        *(f32x4*)(go + ob + 4 * q4) = o;
      }
    }
  }
}

DI void gu_issue(const unsigned char* __restrict__ ub, const unsigned char* __restrict__ x8, const int* idw, int tok, int i, int j, int g, int c,
                 u32x4 (&r)[16], u32x4& hx) {
  i32x4 id[4];
#pragma unroll
  for (int q = 0; q < 4; ++q) id[q] = *(const i32x4*)(idw + i * 128 + g * 16 + 4 * q);
  const unsigned so = (unsigned)(j * (16384 * 128) + 16 * c);
#pragma unroll
  for (int b = 0; b < 16; ++b) r[b] = *(const u32x4*)(ub + (size_t)((unsigned)id[b >> 2][b & 3] + so));
  hx = *(const u32x4*)(x8 + (size_t)tok * 1024 + 128 * j + 16 * c);
}
DI void gu_compute(int* accw, int i, int g, int c, int lane, const u32x4 (&r)[16], const u32x4& hx) {
  int pd[16];
#pragma unroll
  for (int b = 0; b < 16; ++b) {
    int acc = __builtin_amdgcn_sdot4((int)r[b][0], (int)hx[0], 0, false);
    acc = __builtin_amdgcn_sdot4((int)r[b][1], (int)hx[1], acc, false);
    acc = __builtin_amdgcn_sdot4((int)r[b][2], (int)hx[2], acc, false);
    pd[b] = __builtin_amdgcn_sdot4((int)r[b][3], (int)hx[3], acc, false);
  }
  const bool b2 = lane & 4, b1 = lane & 2, b0 = lane & 1;
  int q8[8], q4[4], q2[2];
#pragma unroll
  for (int k = 0; k < 8; ++k) { int snd = b2 ? pd[k] : pd[k + 8]; int kp = b2 ? pd[k + 8] : pd[k]; q8[k] = kp + __shfl_xor(snd, 4); }
#pragma unroll
  for (int k = 0; k < 4; ++k) { int snd = b1 ? q8[k] : q8[k + 4]; int kp = b1 ? q8[k + 4] : q8[k]; q4[k] = kp + __shfl_xor(snd, 2); }
#pragma unroll
  for (int k = 0; k < 2; ++k) { int snd = b0 ? q4[k] : q4[k + 2]; int kp = b0 ? q4[k + 2] : q4[k]; q2[k] = kp + __shfl_xor(snd, 1); }
  int* ap = accw + i * 128 + g * 16 + 2 * c;
  ap[0] += q2[0];
  ap[1] += q2[1];
}
DI void gv_issue(const unsigned char* __restrict__ vb, const int* idw, int i, int j, int g, int c, u32x4 (&r)[16]) {
  i32x4 id[4];
#pragma unroll
  for (int q = 0; q < 4; ++q) id[q] = *(const i32x4*)(idw + i * 128 + g * 16 + 4 * q);
  const unsigned so = (unsigned)(j * (16384 * 128) + 16 * c);
#pragma unroll
  for (int b = 0; b < 16; ++b) r[b] = *(const u32x4*)(vb + (size_t)((unsigned)id[b >> 2][b & 3] + so));
}
DI void gv_compute(const Params& p, int layer, const float* accw, int tok, int i, int j, int g, int c, int lane, const u32x4 (&r)[16], bool dry) {
  char* ws = p.ws;
  const size_t oo = (size_t)tok * 1024 + 128 * j + 16 * c + 2 * g;
  const unsigned xin = *(const unsigned*)((const short*)(ws + OFF_XB) + oo);
  f2v o = {bflo(xin), bfhi(xin)};
  f32x4 wv[4];
#pragma unroll
  for (int q = 0; q < 4; ++q) wv[q] = *(const f32x4*)(accw + i * 128 + g * 16 + 4 * q);
  f2v y[8];
#pragma unroll
  for (int q = 0; q < 8; ++q) { y[q][0] = 0.f; y[q][1] = 0.f; }
#pragma unroll
  for (int b = 0; b < 16; ++b) {
    const float wk = wv[b >> 2][b & 3];
    const f2v wk2 = {wk, wk};
#pragma unroll
    for (int q = 0; q < 4; ++q) {
      y[2 * q] += wk2 * __builtin_amdgcn_cvt_pk_f32_fp8((int)r[b][q], false);
      y[2 * q + 1] += wk2 * __builtin_amdgcn_cvt_pk_f32_fp8((int)r[b][q], true);
    }
  }
  const bool b5 = lane & 32, b4 = lane & 16, b3 = lane & 8;
  f2v y4[4], y2[2], y1;
#pragma unroll
  for (int q = 0; q < 4; ++q) {
    f2v snd = b5 ? y[q] : y[q + 4], kp = b5 ? y[q + 4] : y[q];
    y4[q][0] = kp[0] + __shfl_xor(snd[0], 32); y4[q][1] = kp[1] + __shfl_xor(snd[1], 32);
  }
#pragma unroll
  for (int q = 0; q < 2; ++q) {
    f2v snd = b4 ? y4[q] : y4[q + 2], kp = b4 ? y4[q + 2] : y4[q];
    y2[q][0] = kp[0] + __shfl_xor(snd[0], 16); y2[q][1] = kp[1] + __shfl_xor(snd[1], 16);
  }
  {
    f2v snd = b3 ? y2[0] : y2[1], kp = b3 ? y2[1] : y2[0];
    y1[0] = kp[0] + __shfl_xor(snd[0], 8); y1[1] = kp[1] + __shfl_xor(snd[1], 8);
  }
  float* ss2 = (float*)(ws + OFF_SS) + 2 * T;
  if (dry) { if (y1[0] == 123.456f) ss2[tok] = y1[1] + o[0]; return; }
  o += y1;
  if (layer == 1) *(f2v*)(p.out + oo) = o;
  if (layer == 0) {
    *(unsigned*)((short*)(ws + OFF_XB) + oo) = pack2(o[0], o[1]);
    float sq = o[0] * o[0] + o[1] * o[1];
#pragma unroll
    for (int m = 32; m > 0; m >>= 1) sq += __shfl_xor(sq, m);
    if (lane == 0) unsafeAtomicAdd(ss2 + tok, sq);
  }
}

DI void phase_gather(const Params& p, int layer, char* lds, int bid, int nb, bool dry = false) {
  char* ws = p.ws;
  const int lane = lane_id(), wid = p.wv;
  const int gw = bid * NWAVE + wid, nw = nb * NWAVE;
  float* accw = (float*)lds + wid * 2048;
  int* idw = (int*)(lds + NWAVE * 8192) + wid * 2048;
  const int* idxb = (const int*)(ws + OFF_IDX);
  const float* gsv = (const float*)(ws + OFF_G);
  const float* suv = (const float*)(ws + OFF_SUV);
  const float* ssc = (const float*)(ws + OFF_SS) + (layer == 0 ? 1 : 3) * T;
  const unsigned char* ub = (const unsigned char*)(ws + OFF_UB) + (size_t)layer * 16384 * 1024;
  const unsigned char* vb = (const unsigned char*)(ws + OFF_VB) + (size_t)layer * 16384 * 1024;
  const unsigned char* x8 = (const unsigned char*)(ws + OFF_X8);
  const int g = lane >> 3, c = lane & 7;
  for (int base = 0; base + gw < T; base += 16 * nw) {
    int ntok = (T - base - gw + nw - 1) / nw;
    ntok = ntok > 16 ? 16 : ntok;
    if (ntok == 16) {
      int t0[16], t1[16];
      const unsigned eo0 = (unsigned)(base + gw) * 128u + (unsigned)lane, st = (unsigned)nw * 128u;
#pragma unroll
      for (int i = 0; i < 16; ++i) { t0[i] = idxb[eo0 + i * st]; t1[i] = idxb[eo0 + i * st + 64u]; }
#pragma unroll
      for (int i = 0; i < 16; ++i) {
        idw[i * 128 + lane] = t0[i] << 7; idw[i * 128 + 64 + lane] = t1[i] << 7;
        accw[i * 128 + lane] = 0.f; accw[i * 128 + 64 + lane] = 0.f;
      }
    } else {
      for (int i = 0; i < ntok; ++i) {
        const size_t eo = (size_t)(base + i * nw + gw) * 128 + lane;
        idw[i * 128 + lane] = idxb[eo] << 7; idw[i * 128 + 64 + lane] = idxb[eo + 64] << 7;
        accw[i * 128 + lane] = 0.f; accw[i * 128 + 64 + lane] = 0.f;
      }
    }
    const int nit = 8 * ntok;
    u32x4 rA[16], rB[16];
    for (int rep = 0; rep < (PROBE_GU ? 2 : 1); ++rep) {
      if (rep) for (int i = 0; i < ntok; ++i) { accw[i * 128 + lane] = 0.f; accw[i * 128 + 64 + lane] = 0.f; }
      u32x4 hA, hB;
      int ji = 0, ii = 0, ic = 0;
      gu_issue(ub, x8, idw, base + ii * nw + gw, ii, ji, g, c, rA, hA); if (++ii == ntok) { ii = 0; ++ji; }
      for (int it = 0; it < nit; it += 2) {
        if (it + 1 < nit) { gu_issue(ub, x8, idw, base + ii * nw + gw, ii, ji, g, c, rB, hB); if (++ii == ntok) { ii = 0; ++ji; } }
        gu_compute((int*)accw, ic, g, c, lane, rA, hA); if (++ic == ntok) ic = 0;
        if (it + 1 < nit) {
          if (it + 2 < nit) { gu_issue(ub, x8, idw, base + ii * nw + gw, ii, ji, g, c, rA, hA); if (++ii == ntok) { ii = 0; ++ji; } }
          gu_compute((int*)accw, ic, g, c, lane, rB, hB); if (++ic == ntok) ic = 0;
        }
      }
    }
    if (ntok == 16) {
      float su0[16], su1[16], gs0[16], gs1[16];
      const unsigned eo0 = (unsigned)(base + gw) * 128u + (unsigned)lane, st = (unsigned)nw * 128u;
#pragma unroll
      for (int i = 0; i < 16; ++i) { su0[i] = suv[eo0 + i * st]; su1[i] = suv[eo0 + i * st + 64u]; gs0[i] = gsv[eo0 + i * st]; gs1[i] = gsv[eo0 + i * st + 64u]; }
#pragma unroll
      for (int i = 0; i < 16; ++i) {
        const float a0 = (float)((const int*)accw)[i * 128 + lane] * su0[i] * (6.0f / 127.0f), a1 = (float)((const int*)accw)[i * 128 + 64 + lane] * su1[i] * (6.0f / 127.0f);
        accw[i * 128 + lane] = gs0[i] * 0.5f * a0 * (1.0f + erff(a0 * 0.70710678118654752f));
        accw[i * 128 + 64 + lane] = gs1[i] * 0.5f * a1 * (1.0f + erff(a1 * 0.70710678118654752f));
      }
    } else {
      for (int i = 0; i < ntok; ++i) {
        const size_t eo = (size_t)(base + i * nw + gw) * 128 + lane;
        const float a0 = (float)((const int*)accw)[i * 128 + lane] * suv[eo] * (6.0f / 127.0f), a1 = (float)((const int*)accw)[i * 128 + 64 + lane] * suv[eo + 64] * (6.0f / 127.0f);
        accw[i * 128 + lane] = gsv[eo] * 0.5f * a0 * (1.0f + erff(a0 * 0.70710678118654752f));
        accw[i * 128 + 64 + lane] = gsv[eo + 64] * 0.5f * a1 * (1.0f + erff(a1 * 0.70710678118654752f));
      }
    }
    for (int rep = 0; rep < (PROBE_GV ? 2 : 1); ++rep) {
      const bool dryv = dry || (PROBE_GV && rep == 0);
      int ji = 0, ii = 0, jc = 0, ic = 0;
      gv_issue(vb, idw, ii, ji, g, c, rA); if (++ii == ntok) { ii = 0; ++ji; }
      for (int it = 0; it < nit; it += 2) {
        if (it + 1 < nit) { gv_issue(vb, idw, ii, ji, g, c, rB); if (++ii == ntok) { ii = 0; ++ji; } }
        gv_compute(p, layer, accw, base + ic * nw + gw, ic, jc, g, c, lane, rA, dryv); if (++ic == ntok) { ic = 0; ++jc; }
        if (it + 1 < nit) {
          if (it + 2 < nit) { gv_issue(vb, idw, ii, ji, g, c, rA); if (++ii == ntok) { ii = 0; ++ji; } }
          gv_compute(p, layer, accw, base + ic * nw + gw, ic, jc, g, c, lane, rB, dryv); if (++ic == ntok) { ic = 0; ++jc; }
        }
      }
    }
  }
}

DI void phase_convmix(const Params& p, int bid, int nb, bool dry = false) {
  char* ws = p.ws;
  short* cb = (short*)(ws + OFF_CB);
  const short* cz = (const short*)(ws + OFF_CZ);
  const float* cw = p.conv_w;
  for (size_t i = (size_t)bid * NTHR + TIDX; i < (size_t)T * 128; i += (size_t)nb * NTHR) {
    const int tok = (int)(i >> 7), ch = (int)(i & 127) * 8, pos = tok & (SEQ - 1);
    const size_t off = (size_t)tok * 1024 + ch;
    u32x4 bv = *(const u32x4*)(cb + off);
    u32x4 z0 = *(const u32x4*)(cz + off);
    u32x4 z1 = {0, 0, 0, 0}, z2 = {0, 0, 0, 0};
    if (pos >= 1) z1 = *(const u32x4*)(cz + off - 1024);
    if (pos >= 2) z2 = *(const u32x4*)(cz + off - 2048);
    u32x4 o;
#pragma unroll
    for (int j = 0; j < 4; ++j) {
      const int c0 = ch + 2 * j, c1 = c0 + 1;
      float a0 = cw[c0] * bflo(z2[j]) + cw[1024 + c0] * bflo(z1[j]) + cw[2048 + c0] * bflo(z0[j]);
      float a1 = cw[c1] * bfhi(z2[j]) + cw[1024 + c1] * bfhi(z1[j]) + cw[2048 + c1] * bfhi(z0[j]);
      o[j] = pack2(a0 * bflo(bv[j]), a1 * bfhi(bv[j]));
    }
    if (!dry) *(u32x4*)(cb + off) = o;
  }
}

constexpr int N_PHASES = 13;

DI void grid_barrier(const Params& p, unsigned* bar, unsigned gen, int bid, int nb) {
  __syncthreads();
  int ln;
  asm volatile("v_mbcnt_lo_u32_b32 %0, -1, 0\n\tv_mbcnt_hi_u32_b32 %0, -1, %0" : "=v"(ln));
  if (p.wv == 0 && ln == 0) {
    __builtin_amdgcn_fence(__ATOMIC_RELEASE, "agent");
    constexpr int NG = 32;
    const int x = bid & (NG - 1);
    const unsigned gsz = (unsigned)((nb - x + NG - 1) / NG), ngroups = (unsigned)(nb < NG ? nb : NG);
    unsigned* cnt = bar + 16 * (1 + x);
    unsigned* rel = bar + 16 * (1 + NG + x);
    const unsigned old = __hip_atomic_fetch_add(cnt, 1u, __ATOMIC_RELAXED, __HIP_MEMORY_SCOPE_AGENT);
    if (old + 1u == gen * gsz) {
      __hip_atomic_fetch_add(bar, 1u, __ATOMIC_RELAXED, __HIP_MEMORY_SCOPE_AGENT);
      while (__hip_atomic_load(bar, __ATOMIC_RELAXED, __HIP_MEMORY_SCOPE_AGENT) < gen * ngroups) __builtin_amdgcn_s_sleep(8);
      __hip_atomic_store(rel, gen, __ATOMIC_RELAXED, __HIP_MEMORY_SCOPE_AGENT);
    } else {
      while (__hip_atomic_load(rel, __ATOMIC_RELAXED, __HIP_MEMORY_SCOPE_AGENT) < gen) __builtin_amdgcn_s_sleep(16);
    }
    __builtin_amdgcn_fence(__ATOMIC_ACQUIRE, "agent");
  }
  __syncthreads();
}

__global__ void __launch_bounds__(NTHR, 2) mk(Params p_in, int ph_lo, int ph_hi) {
  Params p = p_in;
  p.wv = __builtin_amdgcn_readfirstlane((int)(threadIdx.x >> 6));
  extern __shared__ __attribute__((aligned(16))) char lds[];
  cg::grid_group grid = cg::this_grid();
  const int bid = blockIdx.x, nb = gridDim.x;
  const int vb = ((nb & 7) == 0) ? ((bid & 7) * (nb >> 3) + (bid >> 3)) : bid;
  char* ws = p.ws;
  unsigned* bar = (unsigned*)(ws + OFF_BAR);
  unsigned gen = 0;
  if (ph_lo < 0) grid.sync();
#ifndef PROBE_DUP
#define PROBE_DUP 0
#endif
#define GSYNC grid_barrier(p, bar, ++gen, bid, nb)
#define PHASE(n, call, drycall) if (ph_lo <= (n) && (n) < ph_hi) { if ((PROBE_DUP >> (n)) & 1) { drycall; GSYNC; } call; if ((n) + 1 < ph_hi) GSYNC; }
  PHASE(0, phase_prep(p, lds, bid, nb), phase_prep(p, lds, bid, nb))
  PHASE(1, gemm_phase<EPI_QKV>(p, (const short*)(ws + OFF_WQKVT), (const short*)(ws + OFF_XB), 1536, lds, vb, nb, 0), gemm_phase<EPI_QKV>(p, (const short*)(ws + OFF_WQKVT), (const short*)(ws + OFF_XB), 1536, lds, vb, nb, 0, true, PROBE_GV2))
  PHASE(2, phase_attn(p, lds, bid, nb), phase_attn(p, lds, bid, nb))
  PHASE(3, gemm_phase<EPI_RES>(p, (const short*)(ws + OFF_WOT), (const short*)(ws + OFF_O), 1024, lds, vb, nb, 0), gemm_phase<EPI_RES>(p, (const short*)(ws + OFF_WOT), (const short*)(ws + OFF_O), 1024, lds, vb, nb, 0, true, PROBE_GV2))
  PHASE(4, gemm_phase<EPI_PQ>(p, (const short*)(ws + OFF_WQT), (const short*)(ws + OFF_XB), 2048, lds, vb, nb, 0), gemm_phase<EPI_PQ>(p, (const short*)(ws + OFF_WQT), (const short*)(ws + OFF_XB), 2048, lds, vb, nb, 0, true, PROBE_GV2))
  PHASE(5, phase_score(p, 0, lds, bid, nb), phase_score(p, 0, lds, bid, nb))
  PHASE(6, phase_gather(p, 0, lds, bid, nb), phase_gather(p, 0, lds, bid, nb, true))
  PHASE(7, gemm_phase<EPI_CONVIN>(p, (const short*)(ws + OFF_WINT), (const short*)(ws + OFF_XB), 3072, lds, vb, nb, 1), gemm_phase<EPI_CONVIN>(p, (const short*)(ws + OFF_WINT), (const short*)(ws + OFF_XB), 3072, lds, vb, nb, 1, true, PROBE_GV2))
  PHASE(8, phase_convmix(p, bid, nb), phase_convmix(p, bid, nb, true))
  PHASE(9, gemm_phase<EPI_RES>(p, (const short*)(ws + OFF_WOUTT), (const short*)(ws + OFF_CB), 1024, lds, vb, nb, 1), gemm_phase<EPI_RES>(p, (const short*)(ws + OFF_WOUTT), (const short*)(ws + OFF_CB), 1024, lds, vb, nb, 1, true, PROBE_GV2))
  PHASE(10, gemm_phase<EPI_PQ>(p, (const short*)(ws + OFF_WQT) + (size_t)2048 * 1024, (const short*)(ws + OFF_XB), 2048, lds, vb, nb, 1), gemm_phase<EPI_PQ>(p, (const short*)(ws + OFF_WQT) + (size_t)2048 * 1024, (const short*)(ws + OFF_XB), 2048, lds, vb, nb, 1, true, PROBE_GV2))
  PHASE(11, phase_score(p, 1, lds, bid, nb), phase_score(p, 1, lds, bid, nb))
  PHASE(12, phase_gather(p, 1, lds, bid, nb), phase_gather(p, 1, lds, bid, nb, true))
}

extern "C" void kernel_launch(void* const* d_in, const int* in_sizes, int n_in, void* d_out, int out_size, void* d_ws, size_t ws_size,
                              hipStream_t stream) {
  static int grid_blocks = 0;
  if (!grid_blocks) {
    hipFuncSetAttribute((const void*)mk, hipFuncAttributeMaxDynamicSharedMemorySize, LDS_BYTES);
    int dev = 0, cus = 0, per_cu = 0;
    hipGetDevice(&dev);
    hipDeviceGetAttribute(&cus, hipDeviceAttributeMultiprocessorCount, dev);
    hipOccupancyMaxActiveBlocksPerMultiprocessor(&per_cu, mk, NTHR, LDS_BYTES);
    if (per_cu > 1) per_cu = 1;
    if (per_cu < 1) per_cu = 1;
    grid_blocks = cus * per_cu;
  }
  Params p{};
  p.x = (const float*)d_in[0]; p.norm_mix = (const float*)d_in[1]; p.norm_ffn = (const float*)d_in[2]; p.w_qkv = (const float*)d_in[3];
  p.q_norm = (const float*)d_in[4]; p.k_norm = (const float*)d_in[5]; p.sinks = (const float*)d_in[6]; p.w_o = (const float*)d_in[7];
  p.w_in = (const float*)d_in[8]; p.conv_w = (const float*)d_in[9]; p.w_out = (const float*)d_in[10]; p.w_query = (const float*)d_in[11];
  p.sub_keys = (const float*)d_in[12]; p.peer_u = (const float*)d_in[13]; p.peer_v = (const float*)d_in[14];
  p.out = (float*)d_out; p.ws = (char*)d_ws;
  hipMemsetAsync((char*)d_ws + OFF_BAR, 0, 8192, stream);
#if MULTI_LAUNCH
  for (int ph = 0; ph < N_PHASES; ++ph) {
    hipLaunchKernelGGL(mk, dim3(grid_blocks), dim3(NTHR), LDS_BYTES, stream, p, ph, ph + 1);
  }
#else
  int lo = 0, hi = N_PHASES;
  void* args[] = {&p, &lo, &hi};
  hipError_t e = hipLaunchCooperativeKernel((const void*)mk, dim3(grid_blocks), dim3(NTHR), args, LDS_BYTES, stream);
  if (e != hipSuccess) fprintf(stderr, "cooperative launch failed: %s (grid %d)\n", hipGetErrorString(e), grid_blocks);
#endif
}
```

```cpp
#include <hip/hip_runtime.h>
#include <hip/hip_cooperative_groups.h>
#include <cstdio>
namespace cg = cooperative_groups;

#ifndef PROBE_GV2
#define PROBE_GV2 0
#endif
#ifndef PROBE_GU
#define PROBE_GU 0
#endif
#ifndef PROBE_GV
#define PROBE_GV 0
#endif
#ifndef MULTI_LAUNCH
#define MULTI_LAUNCH 0
#endif

typedef __attribute__((ext_vector_type(8))) short bf16x8;
typedef __attribute__((ext_vector_type(16))) float f32x16;
typedef __attribute__((ext_vector_type(4))) float f32x4;
typedef __attribute__((ext_vector_type(4))) unsigned u32x4;
typedef __attribute__((ext_vector_type(2))) unsigned u32x2;
typedef __attribute__((ext_vector_type(4))) int i32x4;
typedef __bf16 bf2_t __attribute__((ext_vector_type(2)));
typedef float f2_t __attribute__((ext_vector_type(2)));

#define DI __device__ __forceinline__
#define MFMA32(a, b, c) __builtin_amdgcn_mfma_f32_32x32x16_bf16((a), (b), (c), 0, 0, 0)

constexpr int T = 32768;
constexpr int SEQ = 4096;
constexpr float EPS = 1e-6f;

constexpr size_t OFF_WQKVT = 0;
constexpr size_t OFF_WOT   = OFF_WQKVT + (size_t)1536 * 1024 * 2;
constexpr size_t OFF_WINT  = OFF_WOT + (size_t)1024 * 1024 * 2;
constexpr size_t OFF_WOUTT = OFF_WINT + (size_t)3072 * 1024 * 2;
constexpr size_t OFF_WQT   = OFF_WOUTT + (size_t)1024 * 1024 * 2;
constexpr size_t OFF_KEYS  = OFF_WQT + (size_t)2 * 2048 * 1024 * 2;
constexpr size_t OFF_ROPE  = OFF_KEYS + (size_t)2 * 262144 * 2;
constexpr size_t OFF_SS    = OFF_ROPE + (size_t)4096 * 8 * 8;
constexpr size_t OFF_UB    = OFF_SS + (size_t)4 * T * 4;
constexpr size_t OFF_SU    = OFF_UB + (size_t)2 * 16384 * 1024;
constexpr size_t OFF_VB    = OFF_UB + (size_t)2 * 16384 * 1024 * 2;
constexpr size_t OFF_SV    = OFF_VB + (size_t)2 * 16384 * 1024;
constexpr size_t OFF_XB    = OFF_VB + (size_t)2 * 16384 * 1024 * 2;
constexpr size_t OFF_IDX   = OFF_XB + (size_t)T * 1024 * 2;
constexpr size_t OFF_G     = OFF_IDX + (size_t)T * 128 * 4;
constexpr size_t OFF_BIG   = OFF_G + (size_t)T * 128 * 4;
constexpr size_t OFF_Q     = OFF_BIG;
constexpr size_t OFF_K     = OFF_Q + (size_t)T * 1024 * 2;
constexpr size_t OFF_VT    = OFF_K + (size_t)T * 256 * 2;
constexpr size_t OFF_O     = OFF_VT + (size_t)T * 256 * 2;
constexpr size_t OFF_A     = OFF_O + (size_t)T * 1024 * 2;
constexpr size_t OFF_SUV   = OFF_A + (size_t)T * 128 * 4;
constexpr size_t OFF_X8    = OFF_SUV + (size_t)T * 128 * 4;
constexpr size_t OFF_BAR   = OFF_X8 + (size_t)T * 1024;
constexpr size_t OFF_PQ    = OFF_BIG;
constexpr size_t OFF_CB    = OFF_BIG;
constexpr size_t OFF_CZ    = OFF_CB + (size_t)T * 1024 * 2;

constexpr int NTHR = 512, NWAVE = 8;
constexpr int LDS_BYTES = 147456;
constexpr int LROW = 144;
constexpr int LSTAGE = 73728;
constexpr int LBOFF = 36864;

struct Params {
  const float* x; const float* norm_mix; const float* norm_ffn; const float* w_qkv; const float* q_norm; const float* k_norm;
  const float* sinks; const float* w_o; const float* w_in; const float* conv_w; const float* w_out; const float* w_query;
  const float* sub_keys; const float* peer_u; const float* peer_v;
  float* out; char* ws;
  int wv; int pad_;
};

DI unsigned pack2(float a, float b) { f2_t v = {a, b}; bf2_t r = __builtin_convertvector(v, bf2_t); return __builtin_bit_cast(unsigned, r); }
DI float bflo(unsigned u) { return __uint_as_float(u << 16); }
DI float bfhi(unsigned u) { return __uint_as_float(u & 0xffff0000u); }
DI int lane_id() { return (int)__builtin_amdgcn_mbcnt_hi(~0u, __builtin_amdgcn_mbcnt_lo(~0u, 0u)); }
#define TIDX (p.wv * 64 + lane_id())
DI int crow(int r, int half) { return (r & 3) + 8 * (r >> 2) + 4 * half; }

DI void transpose_job(const float* __restrict__ W, int N, short* __restrict__ Wt, const float* __restrict__ gain, bool winmap,
                      float* tlb, int bid, int nb, int tidx) {
  const int tid = tidx & 255, hb = tidx >> 8;
  float* tl = tlb + hb * (64 * 65);
  const int vbid = bid * 2 + hb, vnb = nb * 2;
  const int ntn = N >> 6;
  const int ntiles = ntn * 16;
  const int iters = (ntiles + vnb - 1) / vnb;
  for (int it = 0; it < iters; ++it) {
    const int tile = it * vnb + vbid;
    const bool act = tile < ntiles;
    const int tn = tile % ntn, tk = tile / ntn;
    const int v0 = tn << 6, k0 = tk << 6;
    __syncthreads();
    if (act) {
      const int j = tid & 63;
      int v = v0 + j, col = v;
      if (winmap && v >= 1024) {
        int w = v - 1024; int bz = w >> 7, i = w & 127; int wmm = i >> 6, mt = (i >> 5) & 1, rr = i & 31;
        col = (mt ? 2048 : 1024) + 64 * bz + 32 * wmm + rr;
      }
#pragma unroll
      for (int i = 0; i < 16; ++i) {
        int kk = (tid >> 6) + 4 * i;
        float val = W[(size_t)(k0 + kk) * N + col];
        if (gain) val *= gain[k0 + kk];
        tl[kk * 65 + j] = val;
      }
    }
    __syncthreads();
    if (act) {
#pragma unroll
      for (int c = 0; c < 2; ++c) {
        int chunk = tid + 256 * c;
        int n = chunk >> 3, kc = chunk & 7;
        u32x4 o;
        o[0] = pack2(tl[(kc * 8 + 0) * 65 + n], tl[(kc * 8 + 1) * 65 + n]);
        o[1] = pack2(tl[(kc * 8 + 2) * 65 + n], tl[(kc * 8 + 3) * 65 + n]);
        o[2] = pack2(tl[(kc * 8 + 4) * 65 + n], tl[(kc * 8 + 5) * 65 + n]);
        o[3] = pack2(tl[(kc * 8 + 6) * 65 + n], tl[(kc * 8 + 7) * 65 + n]);
        *(u32x4*)(Wt + (size_t)(v0 + n) * 1024 + k0 + kc * 8) = o;
      }
    }
  }
}

DI void convert_job(const float* __restrict__ src, short* __restrict__ dst, size_t n8, int bid, int nb, int tidx) {
  for (size_t i = (size_t)bid * NTHR + tidx; i < n8; i += (size_t)nb * NTHR) {
    f32x4 a = *(const f32x4*)(src + i * 8), b = *(const f32x4*)(src + i * 8 + 4);
    u32x4 o; o[0] = pack2(a[0], a[1]); o[1] = pack2(a[2], a[3]); o[2] = pack2(b[0], b[1]); o[3] = pack2(b[2], b[3]);
    *(u32x4*)(dst + i * 8) = o;
  }
}

typedef float f2v __attribute__((ext_vector_type(2)));
DI void fp8_job(const float* __restrict__ src, unsigned char* __restrict__ dst, float* __restrict__ scale, int nrows, const float* __restrict__ gain, int bid, int nb, int tidx) {
  const int lane = tidx & 63, gw = bid * NWAVE + (tidx >> 6), nw = nb * NWAVE;
  for (int row = gw; row < nrows; row += nw) {
    const float* rp = src + (size_t)row * 1024 + lane * 16;
    f32x4 a[4];
    float mx = 0.f;
#pragma unroll
    for (int j = 0; j < 4; ++j) { a[j] = *(const f32x4*)(rp + 4 * j); if (gain) a[j] *= *(const f32x4*)(gain + (row >> 14) * 1024 + lane * 16 + 4 * j); mx = fmaxf(mx, fmaxf(fmaxf(fabsf(a[j][0]), fabsf(a[j][1])), fmaxf(fabsf(a[j][2]), fabsf(a[j][3])))); }
#pragma unroll
    for (int m = 32; m > 0; m >>= 1) mx = fmaxf(mx, __shfl_xor(mx, m));
    mx = fmaxf(mx, 1e-30f);
    const float inv = 224.0f / mx;
    u32x4 o;
#pragma unroll
    for (int j = 0; j < 4; ++j) {
      int w = 0;
      w = __builtin_amdgcn_cvt_pk_fp8_f32(a[j][0] * inv, a[j][1] * inv, w, false);
      w = __builtin_amdgcn_cvt_pk_fp8_f32(a[j][2] * inv, a[j][3] * inv, w, true);
      o[j] = (unsigned)w;
    }
    *(u32x4*)(dst + (size_t)(row >> 14) * (16384 * 1024) + (size_t)(lane >> 3) * (16384 * 128) + (size_t)(row & 16383) * 128 + (lane & 7) * 16) = o;
    if (lane == 0) scale[row] = mx * (1.0f / 224.0f);
  }
}

DI void i8_job(const float* __restrict__ src, unsigned char* __restrict__ dst, float* __restrict__ scale, int nrows, const float* __restrict__ gain, int bid, int nb, int tidx) {
  const int lane = tidx & 63, gw = bid * NWAVE + (tidx >> 6), nw = nb * NWAVE;
  for (int row = gw; row < nrows; row += nw) {
    const float* rp = src + (size_t)row * 1024 + lane * 16;
    f32x4 a[4];
    float mx = 0.f;
#pragma unroll
    for (int j = 0; j < 4; ++j) { a[j] = *(const f32x4*)(rp + 4 * j); a[j] *= *(const f32x4*)(gain + (row >> 14) * 1024 + lane * 16 + 4 * j); mx = fmaxf(mx, fmaxf(fmaxf(fabsf(a[j][0]), fabsf(a[j][1])), fmaxf(fabsf(a[j][2]), fabsf(a[j][3])))); }
#pragma unroll
    for (int m = 32; m > 0; m >>= 1) mx = fmaxf(mx, __shfl_xor(mx, m));
    mx = fmaxf(mx, 1e-30f);
    const float inv = 127.0f / mx;
    u32x4 o;
#pragma unroll
    for (int j = 0; j < 4; ++j) {
      unsigned w = 0;
#pragma unroll
      for (int e = 0; e < 4; ++e) { int q = __float2int_rn(a[j][e] * inv); q = q > 127 ? 127 : (q < -127 ? -127 : q); w |= ((unsigned)q & 0xffu) << (8 * e); }
      o[j] = w;
    }
    *(u32x4*)(dst + (size_t)(row >> 14) * (16384 * 1024) + (size_t)(lane >> 3) * (16384 * 128) + (size_t)(row & 16383) * 128 + (lane & 7) * 16) = o;
    if (lane == 0) scale[row] = mx * (1.0f / 127.0f);
  }
}

DI void phase_prep(const Params& p, char* lds, int bid, int nb) {
  char* ws = p.ws;
  float* tl = (float*)lds;
  const int tidx = TIDX;
  transpose_job(p.w_qkv, 1536, (short*)(ws + OFF_WQKVT), p.norm_mix, false, tl, bid, nb, tidx);
  transpose_job(p.w_o, 1024, (short*)(ws + OFF_WOT), nullptr, false, tl, bid, nb, tidx);
  transpose_job(p.w_in, 3072, (short*)(ws + OFF_WINT), p.norm_mix + 1024, true, tl, bid, nb, tidx);
  transpose_job(p.w_out, 1024, (short*)(ws + OFF_WOUTT), nullptr, false, tl, bid, nb, tidx);
  transpose_job(p.w_query, 2048, (short*)(ws + OFF_WQT), p.norm_ffn, false, tl, bid, nb, tidx);
  transpose_job(p.w_query + (size_t)1024 * 2048, 2048, (short*)(ws + OFF_WQT) + (size_t)2048 * 1024, p.norm_ffn + 1024, false, tl, bid, nb, tidx);
  convert_job(p.sub_keys, (short*)(ws + OFF_KEYS), (size_t)2 * 262144 / 8, bid, nb, tidx);
  i8_job(p.peer_u, (unsigned char*)(ws + OFF_UB), (float*)(ws + OFF_SU), 2 * 16384, p.norm_ffn, bid, nb, tidx);
  fp8_job(p.peer_v, (unsigned char*)(ws + OFF_VB), (float*)(ws + OFF_SV), 2 * 16384, nullptr, bid, nb, tidx);
  float* ss = (float*)(ws + OFF_SS);
  for (int i = bid * NTHR + tidx; i < T; i += nb * NTHR) {
    ss[T + i] = 0.f; ss[2 * T + i] = 0.f; ss[3 * T + i] = 0.f;
    const int pos = i >> 3, d = i & 7;
    const float fr[8] = {1.0f, 0.19392274f, 0.03760603f, 0.0072926646f, 0.0014142136f, 0.0002742482f, 5.3182957e-05f, 1.0313385e-05f};
    float f = d == 0 ? fr[0] : d == 1 ? fr[1] : d == 2 ? fr[2] : d == 3 ? fr[3] : d == 4 ? fr[4] : d == 5 ? fr[5] : d == 6 ? fr[6] : fr[7];
    float ang = (float)pos * f;
    ((float2*)(ws + OFF_ROPE))[i] = make_float2((float)cos((double)ang), (float)sin((double)ang));
  }
  {
    const int lane = tidx & 63, gw = bid * NWAVE + (tidx >> 6), nw = nb * NWAVE;
    short* xb = (short*)(ws + OFF_XB);
    for (int tok = gw; tok < T; tok += nw) {
      const float* xr = p.x + (size_t)tok * 1024;
      float s = 0.f;
#pragma unroll
      for (int hh = 0; hh < 2; ++hh) {
        f32x4 a = *(const f32x4*)(xr + hh * 512 + lane * 8), b = *(const f32x4*)(xr + hh * 512 + lane * 8 + 4);
        s += a[0] * a[0] + a[1] * a[1] + a[2] * a[2] + a[3] * a[3] + b[0] * b[0] + b[1] * b[1] + b[2] * b[2] + b[3] * b[3];
        u32x4 o; o[0] = pack2(a[0], a[1]); o[1] = pack2(a[2], a[3]); o[2] = pack2(b[0], b[1]); o[3] = pack2(b[2], b[3]);
        *(u32x4*)(xb + (size_t)tok * 1024 + hh * 512 + lane * 8) = o;
      }
#pragma unroll
      for (int m = 32; m > 0; m >>= 1) s += __shfl_xor(s, m);
      if (lane == 0) ss[tok] = s;
    }
  }
}

enum { EPI_QKV = 0, EPI_RES = 1, EPI_PQ = 2, EPI_CONVIN = 3 };

template <int EPI, int SUB>
DI void epilogue(const Params& p, f32x16 (&acc)[4][2], int fb, int tb, int lane, int layer, bool dry) {
  char* ws = p.ws;
  const int l32 = lane & 31, half = lane >> 5;
  float* ss = (float*)(ws + OFF_SS);
  if (EPI == EPI_QKV) {
    const int hd = fb >> 6;
#pragma unroll
    for (int nt = 0; nt < 2; ++nt) {
      const int tok = tb + nt * 32 + l32, pos = tok & (SEQ - 1), bb = tok >> 12;
      const float rs0 = rsqrtf(ss[tok] * (1.0f / 1024.0f) + EPS);
      if (hd < 20) {
        float sq = 0.f;
#pragma unroll
        for (int mt = 0; mt < 2; ++mt)
#pragma unroll
          for (int r = 0; r < 16; ++r) { float v = acc[2 * SUB + mt][nt][r] * rs0; sq += v * v; }
        sq += __shfl_xor(sq, 32);
        const float rs = rsqrtf(sq * (1.0f / 64.0f) + EPS) * rs0;
        const float* gain = hd < 16 ? p.q_norm : p.k_norm;
        const float sc = hd < 16 ? 0.125f : 1.0f;
        float v[2][16];
#pragma unroll
        for (int mt = 0; mt < 2; ++mt)
#pragma unroll
          for (int r = 0; r < 16; ++r) v[mt][r] = acc[2 * SUB + mt][nt][r] * rs * gain[mt * 32 + crow(r, half)];
        const float2* rt = (const float2*)(ws + OFF_ROPE) + pos * 8 + 4 * half;
#pragma unroll
        for (int r = 0; r < 4; ++r) {
          float2 cs = rt[r];
          float x1 = v[0][r], x2 = v[0][r + 4];
          v[0][r] = x1 * cs.x - x2 * cs.y;
          v[0][r + 4] = x2 * cs.x + x1 * cs.y;
        }
        short* dst = hd < 16 ? (short*)(ws + OFF_Q) + (size_t)tok * 1024 + hd * 64 : (short*)(ws + OFF_K) + (size_t)tok * 256 + (hd - 16) * 64;
#pragma unroll
        for (int mt = 0; mt < 2; ++mt)
#pragma unroll
          for (int g4 = 0; g4 < 4; ++g4) {
            u32x2 o; o[0] = pack2(v[mt][4 * g4] * sc, v[mt][4 * g4 + 1] * sc); o[1] = pack2(v[mt][4 * g4 + 2] * sc, v[mt][4 * g4 + 3] * sc);
            *(u32x2*)(dst + mt * 32 + 8 * g4 + 4 * half) = o;
          }
      } else {
        const int hk = hd - 20;
        unsigned short* vt = (unsigned short*)(ws + OFF_VT) + ((size_t)(bb * 4 + hk) * 64) * SEQ + pos;
#pragma unroll
        for (int mt = 0; mt < 2; ++mt)
#pragma unroll
          for (int r = 0; r < 16; ++r) {
            const int d = mt * 32 + crow(r, half);
            vt[(size_t)d * SEQ] = (unsigned short)(pack2(acc[2 * SUB + mt][nt][r] * rs0, 0.f) & 0xffffu);
          }
      }
    }
  } else if (EPI == EPI_RES) {
    const float* resid = layer == 0 ? p.x : p.out;
    float* ssn = ss + (layer == 0 ? 1 : 3) * T;
    short* xb = (short*)(ws + OFF_XB);
#pragma unroll
    for (int nt = 0; nt < 2; ++nt) {
      const int tok = tb + nt * 32 + l32;
      float sq = 0.f;
#pragma unroll
      for (int mt = 0; mt < 2; ++mt)
#pragma unroll
        for (int g4 = 0; g4 < 4; ++g4) {
          const size_t off = (size_t)tok * 1024 + fb + mt * 32 + 8 * g4 + 4 * half;
          f32x4 r = *(const f32x4*)(resid + off);
          f32x4 o;
#pragma unroll
          for (int j = 0; j < 4; ++j) { o[j] = r[j] + acc[2 * SUB + mt][nt][4 * g4 + j]; sq += o[j] * o[j]; }
          if (!dry) *(f32x4*)(p.out + off) = o;
          u32x2 ob; ob[0] = pack2(o[0], o[1]); ob[1] = pack2(o[2], o[3]);
          *(u32x2*)(xb + off) = ob;
          { int w8 = 0; w8 = __builtin_amdgcn_cvt_pk_fp8_f32(o[0], o[1], w8, false); w8 = __builtin_amdgcn_cvt_pk_fp8_f32(o[2], o[3], w8, true); *(int*)(ws + OFF_X8 + off) = w8; }
        }
      sq += __shfl_xor(sq, 32);
      if (half == 0 && !dry) unsafeAtomicAdd(ssn + tok, sq);
    }
  } else if (EPI == EPI_PQ) {
    const float* ssc = ss + (layer == 0 ? 1 : 3) * T;
    short* pq = (short*)(ws + OFF_PQ);
#pragma unroll
    for (int nt = 0; nt < 2; ++nt) {
      const int tok = tb + nt * 32 + l32;
      const float rs = rsqrtf(ssc[tok] * (1.0f / 1024.0f) + EPS);
#pragma unroll
      for (int mt = 0; mt < 2; ++mt)
#pragma unroll
        for (int g4 = 0; g4 < 4; ++g4) {
          u32x2 o; o[0] = pack2(acc[2 * SUB + mt][nt][4 * g4] * rs, acc[2 * SUB + mt][nt][4 * g4 + 1] * rs);
          o[1] = pack2(acc[2 * SUB + mt][nt][4 * g4 + 2] * rs, acc[2 * SUB + mt][nt][4 * g4 + 3] * rs);
          *(u32x2*)(pq + (size_t)tok * 2048 + fb + mt * 32 + 8 * g4 + 4 * half) = o;
        }
    }
  } else {
    const float* ssc = ss + 2 * T;
#pragma unroll
    for (int nt = 0; nt < 2; ++nt) {
      const int tok = tb + nt * 32 + l32;
      const float rs = rsqrtf(ssc[tok] * (1.0f / 1024.0f) + EPS);
      if (fb < 1024) {
        short* cb = (short*)(ws + OFF_CB);
#pragma unroll
        for (int mt = 0; mt < 2; ++mt)
#pragma unroll
          for (int g4 = 0; g4 < 4; ++g4) {
            u32x2 o; o[0] = pack2(acc[2 * SUB + mt][nt][4 * g4] * rs, acc[2 * SUB + mt][nt][4 * g4 + 1] * rs);
            o[1] = pack2(acc[2 * SUB + mt][nt][4 * g4 + 2] * rs, acc[2 * SUB + mt][nt][4 * g4 + 3] * rs);
            *(u32x2*)(cb + (size_t)tok * 1024 + fb + mt * 32 + 8 * g4 + 4 * half) = o;
          }
      } else {
        const int w = fb - 1024;
        const int chb = (w >> 7) * 64 + ((w >> 6) & 1) * 32;
        short* cz = (short*)(ws + OFF_CZ);
        const float rs2 = rs * rs;
#pragma unroll
        for (int g4 = 0; g4 < 4; ++g4) {
          float z0 = acc[2 * SUB][nt][4 * g4] * acc[2 * SUB + 1][nt][4 * g4] * rs2, z1 = acc[2 * SUB][nt][4 * g4 + 1] * acc[2 * SUB + 1][nt][4 * g4 + 1] * rs2;
          float z2 = acc[2 * SUB][nt][4 * g4 + 2] * acc[2 * SUB + 1][nt][4 * g4 + 2] * rs2, z3 = acc[2 * SUB][nt][4 * g4 + 3] * acc[2 * SUB + 1][nt][4 * g4 + 3] * rs2;
          u32x2 o; o[0] = pack2(z0, z1); o[1] = pack2(z2, z3);
          *(u32x2*)(cz + (size_t)tok * 1024 + chb + 8 * g4 + 4 * half) = o;
        }
      }
    }
  }
}

typedef __attribute__((ext_vector_type(4))) float f32x4v;
constexpr int G_HT = 128 * 64;
DI int g_lds_byte(int r, int c) { int st = (r >> 4) * 2 + (c >> 5), rr = r & 15, cc = c & 31, ob = rr * 64 + cc * 2; return st * 1024 + (ob ^ (((ob >> 9) & 1) << 5)); }
DI void g_stage_rc(int b, int& R, int& C) { int st = b / 1024, sb = b % 1024, swz = sb ^ (((sb >> 9) & 1) << 5); R = (st >> 1) * 16 + swz / 64; C = (st & 1) * 32 + (swz % 64) / 2; }

template <int NM>
DI void wave_store_rows(char* lb, const u32x2 (&v)[2][4], int lane, short* dst, size_t pitch) {
  const int fr = lane & 15, fq = lane >> 4;
#pragma unroll
  for (int n = 0; n < 2; ++n)
#pragma unroll
    for (int m = 0; m < NM; ++m) *(u32x2*)(lb + (n * 16 + fr) * 144 + m * 32 + fq * 8) = v[n][m];
  constexpr int LPR = NM * 2, RPI = 64 / LPR;
  const int rsub = lane / LPR, ch = lane % LPR;
#pragma unroll
  for (int it = 0; it < 32 / RPI; ++it) {
    const int row = it * RPI + rsub;
    const u32x4 x = *(const u32x4*)(lb + row * 144 + ch * 16);
    *(u32x4*)(dst + (size_t)row * pitch + ch * 8) = x;
  }
}

DI void wave_store_pq(char* lb, const unsigned (&v)[2][4], int lane, unsigned char* pq, int tbase, int fb) {
  const int fr = lane & 15, fq = lane >> 4;
#pragma unroll
  for (int n = 0; n < 2; ++n)
#pragma unroll
    for (int m = 0; m < 4; ++m) *(unsigned*)(lb + (n * 16 + fr) * 72 + m * 16 + fq * 4) = v[n][m];
  const int r = lane & 31, c2 = lane >> 5;
  unsigned char* dst = pq + ((size_t)(tbase >> 5) * 256 + (fb >> 3)) * 256 + r * 8;
#pragma unroll
  for (int it = 0; it < 4; ++it) {
    const int ch = it * 2 + c2;
    const u32x2 x = *(const u32x2*)(lb + r * 72 + ch * 8);
    *(u32x2*)(dst + (size_t)ch * 256) = x;
  }
}

template <int EPI>
DI void epilogue8(const Params& p, f32x4v (&acc)[2][2][4][2], char* lb, int fb0, int tb0, int lane, int layer, bool dry) {
  char* ws = p.ws;
  const int fr = lane & 15, fq = lane >> 4;
  float* ss = (float*)(ws + OFF_SS);
#pragma unroll
  for (int ai = 0; ai < 2; ++ai) {
    const int fb = fb0 + ai * 128;
#pragma unroll
    for (int bj = 0; bj < 2; ++bj) {
      const int tbase = tb0 + bj * 128;
      u32x2 ov[2][4];
      if (EPI == EPI_QKV) {
        const int hd = fb >> 6;
        if (hd < 20) {
#pragma unroll
          for (int n = 0; n < 2; ++n) {
            const int tok = tbase + n * 16 + fr, pos = tok & (SEQ - 1);
            const float rs0 = rsqrtf(ss[tok] * (1.0f / 1024.0f) + EPS);
            float sq = 0.f;
#pragma unroll
            for (int m = 0; m < 4; ++m)
#pragma unroll
              for (int j = 0; j < 4; ++j) { float v = acc[ai][bj][m][n][j] * rs0; sq += v * v; }
            sq += __shfl_xor(sq, 16);
            sq += __shfl_xor(sq, 32);
            const float rs = rsqrtf(sq * (1.0f / 64.0f) + EPS) * rs0;
            const float* gain = hd < 16 ? p.q_norm : p.k_norm;
            const float sc = hd < 16 ? 0.125f : 1.0f;
            const float2* rt = (const float2*)(ws + OFF_ROPE) + pos * 8 + 4 * (fq & 1);
#pragma unroll
            for (int m = 0; m < 4; ++m) {
              const f32x4 gv = *(const f32x4*)(gain + m * 16 + fq * 4);
              float v[4];
#pragma unroll
              for (int j = 0; j < 4; ++j) v[j] = acc[ai][bj][m][n][j] * rs * gv[j];
              if (m == 0) {
#pragma unroll
                for (int j = 0; j < 4; ++j) {
                  const float mine = v[j], other = __shfl_xor(mine, 32);
                  const float2 cs = rt[j];
                  v[j] = (fq < 2) ? (mine * cs.x - other * cs.y) : (mine * cs.x + other * cs.y);
                }
              }
              ov[n][m][0] = pack2(v[0] * sc, v[1] * sc); ov[n][m][1] = pack2(v[2] * sc, v[3] * sc);
            }
          }
          short* dst = hd < 16 ? (short*)(ws + OFF_Q) + (size_t)tbase * 1024 + hd * 64 : (short*)(ws + OFF_K) + (size_t)tbase * 256 + (hd - 16) * 64;
          wave_store_rows<4>(lb, ov, lane, dst, hd < 16 ? 1024 : 256);
        } else {
          const int hk = hd - 20;
#pragma unroll
          for (int n = 0; n < 2; ++n) {
            const int tok = tbase + n * 16 + fr;
            const float rs0 = rsqrtf(ss[tok] * (1.0f / 1024.0f) + EPS);
#pragma unroll
            for (int m = 0; m < 4; ++m)
#pragma unroll
              for (int j = 0; j < 4; ++j)
                *(unsigned short*)(lb + (m * 16 + fq * 4 + j) * 80 + (n * 16 + fr) * 2) = (unsigned short)(pack2(acc[ai][bj][m][n][j] * rs0, 0.f) & 0xffffu);
          }
          const int bb = tbase >> 12, pos0 = tbase & (SEQ - 1);
          unsigned short* vt = (unsigned short*)(ws + OFF_VT) + ((size_t)(bb * 4 + hk) * 64) * SEQ + pos0;
          const int rsub = lane >> 2, ch = lane & 3;
#pragma unroll
          for (int it = 0; it < 4; ++it) {
            const int d = it * 16 + rsub;
            const u32x4 x = *(const u32x4*)(lb + d * 80 + ch * 16);
            *(u32x4*)(vt + (size_t)d * SEQ + ch * 8) = x;
          }
        }
      } else if (EPI == EPI_RES) {
        float* ssn = ss + (layer == 0 ? 1 : 3) * T;
        const short* xbr = (const short*)(ws + OFF_XB);
#pragma unroll
        for (int n = 0; n < 2; ++n) {
          const int tok = tbase + n * 16 + fr;
          float sq = 0.f;
#pragma unroll
          for (int m = 0; m < 4; ++m) {
            const size_t off = (size_t)tok * 1024 + fb + m * 16 + fq * 4;
            f32x4 r;
            { const u32x2 rb = *(const u32x2*)(xbr + off); r[0] = bflo(rb[0]); r[1] = bfhi(rb[0]); r[2] = bflo(rb[1]); r[3] = bfhi(rb[1]); }
            f32x4 o;
#pragma unroll
            for (int j = 0; j < 4; ++j) { o[j] = r[j] + acc[ai][bj][m][n][j]; sq += o[j] * o[j]; }
            ov[n][m][0] = pack2(o[0], o[1]); ov[n][m][1] = pack2(o[2], o[3]);
          }
          sq += __shfl_xor(sq, 16);
          sq += __shfl_xor(sq, 32);
          if (fq == 0 && !dry) unsafeAtomicAdd(ssn + tok, sq);
        }
        if (!dry) wave_store_rows<4>(lb, ov, lane, (short*)(ws + OFF_XB) + (size_t)tbase * 1024 + fb, 1024);
      } else if (EPI == EPI_PQ) {
        const float* ssc = ss + (layer == 0 ? 1 : 3) * T;
        unsigned ov8[2][4];
#pragma unroll
        for (int n = 0; n < 2; ++n) {
          const int tok = tbase + n * 16 + fr;
          const float rs = rsqrtf(ssc[tok] * (1.0f / 1024.0f) + EPS);
#pragma unroll
          for (int m = 0; m < 4; ++m) {
            int w8 = 0;
            w8 = __builtin_amdgcn_cvt_pk_fp8_f32(acc[ai][bj][m][n][0] * rs, acc[ai][bj][m][n][1] * rs, w8, false);
            w8 = __builtin_amdgcn_cvt_pk_fp8_f32(acc[ai][bj][m][n][2] * rs, acc[ai][bj][m][n][3] * rs, w8, true);
            ov8[n][m] = (unsigned)w8;
          }
        }
        wave_store_pq(lb, ov8, lane, (unsigned char*)(ws + OFF_PQ), tbase, fb);
      } else {
        const bool isb = fb < 1024;
#pragma unroll
        for (int n = 0; n < 2; ++n) {
          const int tok = tbase + n * 16 + fr;
          const float rs = rsqrtf(ss[2 * T + tok] * (1.0f / 1024.0f) + EPS);
          if (isb) {
#pragma unroll
            for (int m = 0; m < 4; ++m) {
              ov[n][m][0] = pack2(acc[ai][bj][m][n][0] * rs, acc[ai][bj][m][n][1] * rs);
              ov[n][m][1] = pack2(acc[ai][bj][m][n][2] * rs, acc[ai][bj][m][n][3] * rs);
            }
          } else {
            const float rs2 = rs * rs;
#pragma unroll
            for (int m = 0; m < 2; ++m) {
              ov[n][m][0] = pack2(acc[ai][bj][m][n][0] * acc[ai][bj][m + 2][n][0] * rs2, acc[ai][bj][m][n][1] * acc[ai][bj][m + 2][n][1] * rs2);
              ov[n][m][1] = pack2(acc[ai][bj][m][n][2] * acc[ai][bj][m + 2][n][2] * rs2, acc[ai][bj][m][n][3] * acc[ai][bj][m + 2][n][3] * rs2);
              ov[n][m + 2][0] = 0; ov[n][m + 2][1] = 0;
            }
          }
        }
        if (isb) wave_store_rows<4>(lb, ov, lane, (short*)(ws + OFF_CB) + (size_t)tbase * 1024 + fb, 1024);
        else {
          const int w = fb - 1024;
          const int chb = (w >> 7) * 64 + ((w >> 6) & 1) * 32;
          wave_store_rows<2>(lb, ov, lane, (short*)(ws + OFF_CZ) + (size_t)tbase * 1024 + chb, 1024);
        }
      }
    }
  }
}

template <int EPI>
DI void gemm_phase(const Params& p, const short* __restrict__ A, const short* __restrict__ Bt, int Mfeat, char* lds, int vb, int nb, int layer, bool dry = false, int variant = 0) {
  short* shm = (short*)lds;
  constexpr int K = 1024, BK = 64, HALF = 128, nt = K / BK;
#define SA(b, h) (shm + ((b) * 2 + (h)) * G_HT)
#define SB_(b, h) (shm + (4 + (b) * 2 + (h)) * G_HT)
#define STAGE(P, BASE, br, kt) do { const unsigned _o = soff + (unsigned)(((br) * K + (kt) * BK) * 2); \
    __builtin_amdgcn_global_load_lds((const unsigned*)((const char*)(BASE) + (size_t)_o), (unsigned*)((char*)(P) + tidx * 16), 16, 0, 0); \
    __builtin_amdgcn_global_load_lds((const unsigned*)((const char*)(BASE) + (size_t)(_o + 64u * K * 2u)), (unsigned*)((char*)(P) + tidx * 16 + 8192), 16, 0, 0); } while (0)
#define LDA(dst, b, h) _Pragma("unroll") for (int m = 0; m < 4; ++m) _Pragma("unroll") for (int k = 0; k < 2; ++k) \
    dst[m][k] = *reinterpret_cast<const bf16x8*>((char*)SA(b, h) + g_lds_byte(wr * 64 + m * 16 + fr, k * 32 + fq * 8))
#define LDB(dst, b, h) _Pragma("unroll") for (int n = 0; n < 2; ++n) _Pragma("unroll") for (int k = 0; k < 2; ++k) \
    dst[n][k] = *reinterpret_cast<const bf16x8*>((char*)SB_(b, h) + g_lds_byte(wc * 32 + n * 16 + fr, k * 32 + fq * 8))
#define MMA(ai, bj, At_, Bt_) do { __builtin_amdgcn_s_setprio(1); \
    _Pragma("unroll") for (int m = 0; m < 4; ++m) _Pragma("unroll") for (int n = 0; n < 2; ++n) _Pragma("unroll") for (int k = 0; k < 2; ++k) \
      acc[ai][bj][m][n] = __builtin_amdgcn_mfma_f32_16x16x32_bf16(At_[m][k], Bt_[n][k], acc[ai][bj][m][n], 0, 0, 0); \
    __builtin_amdgcn_s_setprio(0); } while (0)
#define WAIT_V(n) asm volatile("s_waitcnt vmcnt(" #n ")" ::: "memory")
#define WAIT_L(n) asm volatile("s_waitcnt lgkmcnt(" #n ")" ::: "memory")
#define BAR __builtin_amdgcn_s_barrier()
#define SCHED __builtin_amdgcn_sched_barrier(0)
  const int tidx = TIDX;
  const int wid = tidx >> 6, lane = tidx & 63, wr = wid >> 2, wc = wid & 3, fr = lane & 15, fq = lane >> 4;
  int sR, sC;
  g_stage_rc(tidx * 16, sR, sC);
  const unsigned soff = (unsigned)(sR * K + sC) * 2u;
  const int mtiles = Mfeat >> 8;
  const int ntiles = mtiles * (T / 256);
  for (int tile = vb; tile < ntiles; tile += nb) {
    const int tm = tile % mtiles, tn = tile / mtiles;
    const int brow = tm << 8, bcol = tn << 8;
    f32x4v acc[2][2][4][2];
#pragma unroll
    for (int a = 0; a < 2; ++a)
#pragma unroll
      for (int b = 0; b < 2; ++b)
#pragma unroll
        for (int m = 0; m < 4; ++m)
#pragma unroll
          for (int n = 0; n < 2; ++n) acc[a][b][m][n] = f32x4v{0.f, 0.f, 0.f, 0.f};
    bf16x8 At[4][2], B0[2][2], B1[2][2];
    STAGE(SB_(0, 0), Bt, bcol, 0); STAGE(SA(0, 0), A, brow, 0);
    STAGE(SB_(0, 1), Bt, bcol + HALF, 0); STAGE(SA(0, 1), A, brow + HALF, 0);
    if (wr == 1) BAR;
    WAIT_V(4); BAR;
    STAGE(SB_(1, 0), Bt, bcol, 1); STAGE(SA(1, 0), A, brow, 1); STAGE(SB_(1, 1), Bt, bcol + HALF, 1);
    WAIT_V(6); BAR;
    for (int t = 0; t < nt - 2; t += 2) {
      LDB(B0, 0, 0); SCHED; LDA(At, 0, 0); STAGE(SA(1, 1), A, brow + HALF, t + 1);
      WAIT_L(8); BAR; WAIT_L(0); MMA(0, 0, At, B0); BAR; SCHED;
      LDB(B1, 0, 1); STAGE(SB_(0, 0), Bt, bcol, t + 2);
      BAR; WAIT_L(0); MMA(0, 1, At, B1); BAR;
      LDA(At, 0, 1); STAGE(SA(0, 0), A, brow, t + 2);
      BAR; WAIT_L(0); MMA(1, 0, At, B0); BAR; SCHED;
      STAGE(SB_(0, 1), Bt, bcol + HALF, t + 2);
      WAIT_V(6); BAR; MMA(1, 1, At, B1); BAR;
      LDB(B0, 1, 0); SCHED; LDA(At, 1, 0); STAGE(SA(0, 1), A, brow + HALF, t + 2);
      WAIT_L(8); BAR; WAIT_L(0); MMA(0, 0, At, B0); BAR; SCHED;
      LDB(B1, 1, 1); STAGE(SB_(1, 0), Bt, bcol, t + 3);
      BAR; WAIT_L(0); MMA(0, 1, At, B1); BAR;
      LDA(At, 1, 1); STAGE(SA(1, 0), A, brow, t + 3);
      BAR; WAIT_L(0); MMA(1, 0, At, B0); BAR; SCHED;
      STAGE(SB_(1, 1), Bt, bcol + HALF, t + 3);
      WAIT_V(6); BAR; MMA(1, 1, At, B1); BAR;
    }
    { LDB(B0, 0, 0); LDA(At, 0, 0); STAGE(SA(1, 1), A, brow + HALF, nt - 1);
      BAR; WAIT_L(0); MMA(0, 0, At, B0); BAR;
      LDB(B1, 0, 1); BAR; WAIT_L(0); MMA(0, 1, At, B1); BAR;
      LDA(At, 0, 1); WAIT_V(4); BAR; WAIT_L(0); MMA(1, 0, At, B0); MMA(1, 1, At, B1); BAR; }
    { LDB(B0, 1, 0); LDA(At, 1, 0); WAIT_V(2); BAR; WAIT_L(0); MMA(0, 0, At, B0); BAR;
      LDB(B1, 1, 1); WAIT_V(0); BAR; WAIT_L(0); MMA(0, 1, At, B1); BAR;
      LDA(At, 1, 1); BAR; WAIT_L(0); MMA(1, 0, At, B0); MMA(1, 1, At, B1); BAR; }
    if (wr == 0) BAR;
    __builtin_amdgcn_sched_barrier(0);
    epilogue8<EPI>(p, acc, lds + wid * 5120, brow + wr * 64, bcol + wc * 32, lane, layer, dry);
    WAIT_V(0);
    __syncthreads();
  }
  __syncthreads();
}

constexpr int AK_PITCH = 144;
constexpr int AV_PITCH = 528;
constexpr int AV_OFF = 256 * AK_PITCH;
DI void phase_attn(const Params& p, char* lds, int bid, int nb) {
  char* ws = p.ws;
  const int lane = lane_id(), wid = p.wv, l32 = lane & 31, half = lane >> 5;
  const int tidx = wid * 64 + lane;
  const short* qbuf = (const short*)(ws + OFF_Q);
  const short* kbuf = (const short*)(ws + OFF_K);
  const short* vtb = (const short*)(ws + OFF_VT);
  short* obuf = (short*)(ws + OFF_O);
  for (int blk = bid; blk < 1024; blk += nb) {
    const int hkv = blk & 3, n = (blk >> 2) & 31, b = blk >> 7;
    const int kbase = n * 128 - 128;
    __syncthreads();
#pragma unroll
    for (int i = 0; i < 4; ++i) {
      const int id = tidx + NTHR * i;
      const int key = id >> 3, ch = id & 7;
      if (kbase + key >= 0) *(u32x4*)(lds + key * AK_PITCH + ch * 16) = *(const u32x4*)(kbuf + (size_t)(b * SEQ + kbase + key) * 256 + hkv * 64 + ch * 8);
      const int d = id >> 5, vc = id & 31;
      if (kbase + vc * 8 >= 0) *(u32x4*)(lds + AV_OFF + d * AV_PITCH + vc * 16) = *(const u32x4*)(vtb + ((size_t)(b * 4 + hkv) * 64 + d) * SEQ + kbase + vc * 8);
    }
    __syncthreads();
    const int head = hkv * 4 + (wid & 3);
    const float sink = p.sinks[head];
#pragma unroll 1
    for (int cc = 0; cc < 2; ++cc) {
      const int c = (wid >> 2) * 2 + cc;
      const int qtok = b * SEQ + n * 128 + c * 32 + l32;
      bf16x8 qf[4];
#pragma unroll
      for (int ks = 0; ks < 4; ++ks) qf[ks] = *(const bf16x8*)(qbuf + (size_t)qtok * 1024 + head * 64 + ks * 16 + half * 8);
      f32x16 s[5];
      const int jt0 = (n == 0) ? (4 - c) : 0;
#pragma unroll
      for (int jt = 0; jt < 5; ++jt) {
#pragma unroll
        for (int r = 0; r < 16; ++r) s[jt][r] = 0.f;
        if (jt >= jt0) {
          const char* kp = lds + (32 * (c + jt) + l32) * AK_PITCH + half * 16;
#pragma unroll
          for (int ks = 0; ks < 4; ++ks) {
            bf16x8 kf = *(const bf16x8*)(kp + ks * 32);
            s[jt] = MFMA32(kf, qf[ks], s[jt]);
          }
        }
      }
      float m = sink;
#pragma unroll
      for (int jt = 0; jt < 5; ++jt)
#pragma unroll
        for (int r = 0; r < 16; ++r) {
          const int kr = crow(r, half);
          bool valid = jt >= jt0;
          if (jt == 0) valid = valid && (kr > l32);
          if (jt == 4) valid = valid && (kr <= l32);
          float v = valid ? s[jt][r] : -1e30f;
          s[jt][r] = v;
          m = fmaxf(m, v);
        }
      m = fmaxf(m, __shfl_xor(m, 32));
      float sum = 0.f;
#pragma unroll
      for (int jt = 0; jt < 5; ++jt)
#pragma unroll
        for (int r = 0; r < 16; ++r) { float e = __expf(s[jt][r] - m); s[jt][r] = e; sum += e; }
      sum += __shfl_xor(sum, 32);
      const float inv = 1.0f / (sum + __expf(sink - m));
      f32x16 o[2];
#pragma unroll
      for (int dt = 0; dt < 2; ++dt)
#pragma unroll
        for (int r = 0; r < 16; ++r) o[dt][r] = 0.f;
#pragma unroll
      for (int jt = 0; jt < 5; ++jt) {
        if (jt >= jt0) {
#pragma unroll
          for (int s2 = 0; s2 < 2; ++s2) {
            u32x4 pf;
            pf[0] = pack2(s[jt][8 * s2 + 0], s[jt][8 * s2 + 1]); pf[1] = pack2(s[jt][8 * s2 + 2], s[jt][8 * s2 + 3]);
            pf[2] = pack2(s[jt][8 * s2 + 4], s[jt][8 * s2 + 5]); pf[3] = pack2(s[jt][8 * s2 + 6], s[jt][8 * s2 + 7]);
            bf16x8 pb = __builtin_bit_cast(bf16x8, pf);
#pragma unroll
            for (int dt = 0; dt < 2; ++dt) {
              const char* vp = lds + AV_OFF + (dt * 32 + l32) * AV_PITCH + (32 * (c + jt) + 16 * s2 + 4 * half) * 2;
              u32x2 v0 = *(const u32x2*)(vp), v1 = *(const u32x2*)(vp + 16);
              u32x4 vf; vf[0] = v0[0]; vf[1] = v0[1]; vf[2] = v1[0]; vf[3] = v1[1];
              o[dt] = MFMA32(__builtin_bit_cast(bf16x8, vf), pb, o[dt]);
            }
          }
        }
      }
#pragma unroll
      for (int dt = 0; dt < 2; ++dt)
#pragma unroll
        for (int g4 = 0; g4 < 4; ++g4) {
          u32x2 ob; ob[0] = pack2(o[dt][4 * g4] * inv, o[dt][4 * g4 + 1] * inv); ob[1] = pack2(o[dt][4 * g4 + 2] * inv, o[dt][4 * g4 + 3] * inv);
          *(u32x2*)(obuf + (size_t)qtok * 1024 + head * 64 + dt * 32 + 8 * g4 + 4 * half) = ob;
        }
    }
  }
}

DI int f2key(float f) { int i = __float_as_int(f); return i ^ ((i >> 31) & 0x7fffffff); }
DI float key2f(int k) { return __int_as_float(k ^ ((k >> 31) & 0x7fffffff)); }
#define CEX(a, b) { int _hi = max((a), (b)); int _lo = min((a), (b)); (a) = _hi; (b) = _lo; }

DI void merge16_desc(int (&v)[16]) {
#pragma unroll
  for (int j = 8; j > 0; j >>= 1)
#pragma unroll
    for (int i = 0; i < 16; ++i) { const int l = i ^ j; if (l > i) CEX(v[i], v[l]); }
}
DI void sort16_desc(int (&v)[16]) {
#pragma unroll
  for (int k = 2; k <= 16; k <<= 1)
#pragma unroll
    for (int j = k >> 1; j > 0; j >>= 1)
#pragma unroll
      for (int i = 0; i < 16; ++i) {
        const int l = i ^ j;
        if (l > i) { if ((i & k) == 0) CEX(v[i], v[l]) else CEX(v[l], v[i]); }
      }
}
constexpr unsigned char CAND_I[50] = {0,0,0,0,0,0,0,0,0,0,0,0,0,0,0,0,1,1,1,1,1,1,1,1,2,2,2,2,2,3,3,3,3,4,4,4,5,5,6,6,7,7,8,9,10,11,12,13,14,15};
constexpr unsigned char CAND_J[50] = {0,1,2,3,4,5,6,7,8,9,10,11,12,13,14,15,0,1,2,3,4,5,6,7,0,1,2,3,4,0,1,2,3,0,1,2,0,1,0,1,0,1,0,0,0,0,0,0,0,0};
DI void sort32_desc(int (&v)[32]) {
#pragma unroll
  for (int k = 2; k <= 32; k <<= 1)
#pragma unroll
    for (int j = k >> 1; j > 0; j >>= 1)
#pragma unroll
      for (int i = 0; i < 32; ++i) {
        const int l = i ^ j;
        if (l > i) { if ((i & k) == 0) CEX(v[i], v[l]) else CEX(v[l], v[i]); }
      }
}
DI void topmerge(int (&a)[16], const int (&b)[16]) {
#pragma unroll
  for (int i = 0; i < 16; ++i) a[i] = max(a[i], b[15 - i]);
  merge16_desc(a);
}
DI int sel16(const int (&L)[16], int i) {
  int r = L[0];
#pragma unroll
  for (int q = 1; q < 16; ++q) r = (i == q) ? L[q] : r;
  return r;
}

DI void score_half(const short* __restrict__ pq, const char* klds, int tok, int h, int ph, int l32, int half, int (&top)[16]) {
  bf16x8 qf[8];
#pragma unroll
  for (int ks = 0; ks < 8; ++ks) {
    const u32x2 q8 = *(const u32x2*)((const unsigned char*)pq + ((size_t)(tok >> 5) * 256 + (h * 32 + ph * 16 + ks * 2 + half)) * 256 + (tok & 31) * 8);
    const f2v a0 = __builtin_amdgcn_cvt_pk_f32_fp8((int)q8[0], false), a1 = __builtin_amdgcn_cvt_pk_f32_fp8((int)q8[0], true);
    const f2v a2 = __builtin_amdgcn_cvt_pk_f32_fp8((int)q8[1], false), a3 = __builtin_amdgcn_cvt_pk_f32_fp8((int)q8[1], true);
    u32x4 o; o[0] = pack2(a0[0], a0[1]); o[1] = pack2(a1[0], a1[1]); o[2] = pack2(a2[0], a2[1]); o[3] = pack2(a3[0], a3[1]);
    qf[ks] = __builtin_bit_cast(bf16x8, o);
  }
  const char* kb = klds + l32 * 272 + half * 16;
#pragma unroll 1
  for (int kt = 0; kt < 4; ++kt) {
    f32x16 acc;
#pragma unroll
    for (int r = 0; r < 16; ++r) acc[r] = 0.f;
#pragma unroll
    for (int ks = 0; ks < 8; ++ks) {
      bf16x8 kf = *(const bf16x8*)(kb + kt * 32 * 272 + ks * 32);
      acc = MFMA32(kf, qf[ks], acc);
    }
    int t2[16];
#pragma unroll
    for (int r = 0; r < 16; ++r) t2[r] = (f2key(acc[r]) & ~127) | (kt * 32 + crow(r, half));
    sort16_desc(t2);
    if (kt == 0) {
#pragma unroll
      for (int r = 0; r < 16; ++r) top[r] = t2[r];
    } else topmerge(top, t2);
  }
  int t3[16];
#pragma unroll
  for (int r = 0; r < 16; ++r) t3[r] = __shfl_xor(top[r], 32);
  topmerge(top, t3);
}

DI void phase_score(const Params& p, int layer, char* lds, int bid, int nb) {
  char* ws = p.ws;
  const int lane = lane_id(), wid = p.wv, l32 = lane & 31, half = lane >> 5;
  const short* pq = (const short*)(ws + OFF_PQ);
  const short* keys = (const short*)(ws + OFF_KEYS) + (size_t)layer * 262144;
  int* idxo = (int*)(ws + OFF_IDX);
  float* go = (float*)(ws + OFF_G);
  char* klds = lds + NWAVE * 8192;
  const int tidx = wid * 64 + lane;
  constexpr int KT_BYTES = 128 * 272;
  int hst = -1;
  for (int blk = bid; blk < 8192 / NWAVE; blk += nb) {
    const int h = blk & 7, tt = (blk >> 3) * NWAVE + wid;
    const int tok = tt * 32 + l32;
    {
      const float* ssq = (const float*)(ws + OFF_SS) + (layer == 0 ? 1 : 3) * T;
      const float qs = rsqrtf(ssq[tok] * (1.0f / 1024.0f) + EPS) * (127.0f / 6.0f);
      const short* xr = (const short*)(ws + OFF_XB) + (size_t)tok * 1024 + h * 128 + half * 64;
      unsigned char* xo = (unsigned char*)(ws + OFF_X8) + (size_t)tok * 1024 + h * 128 + half * 64;
#pragma unroll
      for (int q4 = 0; q4 < 4; ++q4) {
        u32x4 xa = *(const u32x4*)(xr + q4 * 16), xc = *(const u32x4*)(xr + q4 * 16 + 8);
        u32x4 o;
#pragma unroll
        for (int d = 0; d < 4; ++d) {
          const unsigned w0 = d < 2 ? xa[2 * d] : xc[2 * d - 4], w1 = d < 2 ? xa[2 * d + 1] : xc[2 * d - 3];
          const float f0 = __builtin_amdgcn_fmed3f(bflo(w0) * qs, -127.f, 127.f) + 12582912.0f, f1 = __builtin_amdgcn_fmed3f(bfhi(w0) * qs, -127.f, 127.f) + 12582912.0f;
          const float f2 = __builtin_amdgcn_fmed3f(bflo(w1) * qs, -127.f, 127.f) + 12582912.0f, f3 = __builtin_amdgcn_fmed3f(bfhi(w1) * qs, -127.f, 127.f) + 12582912.0f;
          o[d] = (__float_as_uint(f0) & 0xffu) | ((__float_as_uint(f1) & 0xffu) << 8) | ((__float_as_uint(f2) & 0xffu) << 16) | (__float_as_uint(f3) << 24);
        }
        *(u32x4*)(xo + q4 * 16) = o;
      }
    }
    if (h != hst) {
      __syncthreads();
#pragma unroll
      for (int i = 0; i < 8; ++i) {
        const int id = tidx + NTHR * i;
        *(u32x4*)(klds + (id >> 11) * KT_BYTES + ((id >> 4) & 127) * 272 + (id & 15) * 16) = *(const u32x4*)(keys + (size_t)h * 32768 + (size_t)(id >> 4) * 128 + (id & 15) * 8);
      }
      __syncthreads();
      hst = h;
    }
    int L0[16], L1[16];
    score_half(pq, klds, tok, h, 0, l32, half, L0);
    score_half(pq, klds + KT_BYTES, tok, h, 1, l32, half, L1);
    float v1[16], v2[16];
#pragma unroll
    for (int r = 0; r < 16; ++r) { v1[r] = key2f(L0[r] & ~127); v2[r] = key2f(L1[r] & ~127); }
    int cand[32];
#pragma unroll
    for (int sI = 0; sI < 25; ++sI) {
      const float va = v1[CAND_I[2 * sI]] + v2[CAND_J[2 * sI]], vb2 = v1[CAND_I[2 * sI + 1]] + v2[CAND_J[2 * sI + 1]];
      const int ca = CAND_I[2 * sI] * 16 + CAND_J[2 * sI], cb = CAND_I[2 * sI + 1] * 16 + CAND_J[2 * sI + 1];
      cand[sI] = (f2key(half ? vb2 : va) & ~255) | (half ? cb : ca);
    }
#pragma unroll
    for (int sI = 25; sI < 32; ++sI) cand[sI] = (int)0x80000000;
    sort32_desc(cand);
    int best[16], bo[16];
#pragma unroll
    for (int r = 0; r < 16; ++r) { best[r] = cand[r]; bo[r] = __shfl_xor(cand[r], 32); }
    topmerge(best, bo);
    int* lw = (int*)lds + wid * 2048 + lane;
#pragma unroll
    for (int r = 0; r < 16; ++r) { lw[r * 64] = L0[r] & 127; lw[(16 + r) * 64] = L1[r] & 127; }
    float sv[16]; int eid[16];
#pragma unroll
    for (int q = 0; q < 16; ++q) {
      const int code = best[q] & 255;
      sv[q] = key2f(best[q] & ~255);
      const int e1 = lw[(code >> 4) * 64], e2 = lw[(16 + (code & 15)) * 64];
      eid[q] = e1 * 128 + e2;
    }
    float sum = 0.f;
    const float mx = sv[0];
#pragma unroll
    for (int q = 0; q < 16; ++q) { sv[q] = __expf(sv[q] - mx); sum += sv[q]; }
    const float inv = 1.0f / sum;
    const size_t ob = ((size_t)tok * 8 + h) * 16;
    const float* sut = (const float*)(ws + OFF_SU) + layer * 16384;
    const float* svt = (const float*)(ws + OFF_SV) + layer * 16384;
    float* suo = (float*)(ws + OFF_SUV);
    if (half == 0) {
#pragma unroll
      for (int q4 = 0; q4 < 4; ++q4) {
        i32x4 o = {eid[4 * q4], eid[4 * q4 + 1], eid[4 * q4 + 2], eid[4 * q4 + 3]}; *(i32x4*)(idxo + ob + 4 * q4) = o;
        f32x4 o2 = {sut[eid[4 * q4]], sut[eid[4 * q4 + 1]], sut[eid[4 * q4 + 2]], sut[eid[4 * q4 + 3]]}; *(f32x4*)(suo + ob + 4 * q4) = o2;
      }
    } else {
#pragma unroll
      for (int q4 = 0; q4 < 4; ++q4) {
        f32x4 o = {sv[4 * q4] * inv * svt[eid[4 * q4]], sv[4 * q4 + 1] * inv * svt[eid[4 * q4 + 1]], sv[4 * q4 + 2] * inv * svt[eid[4 * q4 + 2]], sv[4 * q4 + 3] * inv * svt[eid[4 * q4 + 3]]};
        *(f32x4*)(go + ob + 4 * q4) = o;
      }
    }
  }
}

DI void gu_issue(const unsigned char* __restrict__ ub, const unsigned char* __restrict__ x8, const int* idw, int tok, int i, int j, int g, int c,
                 u32x4 (&r)[16], u32x4& hx) {
  i32x4 id[4];
#pragma unroll
  for (int q = 0; q < 4; ++q) id[q] = *(const i32x4*)(idw + i * 128 + g * 16 + 4 * q);
  const unsigned so = (unsigned)(j * (16384 * 128) + 16 * c);
#pragma unroll
  for (int b = 0; b < 16; ++b) r[b] = *(const u32x4*)(ub + (size_t)((unsigned)id[b >> 2][b & 3] + so));
  hx = *(const u32x4*)(x8 + (size_t)tok * 1024 + 128 * j + 16 * c);
}
DI void gu_compute(int* accw, int i, int g, int c, int lane, const u32x4 (&r)[16], const u32x4& hx) {
  int pd[16];
#pragma unroll
  for (int b = 0; b < 16; ++b) {
    int acc = __builtin_amdgcn_sdot4((int)r[b][0], (int)hx[0], 0, false);
    acc = __builtin_amdgcn_sdot4((int)r[b][1], (int)hx[1], acc, false);
    acc = __builtin_amdgcn_sdot4((int)r[b][2], (int)hx[2], acc, false);
    pd[b] = __builtin_amdgcn_sdot4((int)r[b][3], (int)hx[3], acc, false);
  }
  const bool b2 = lane & 4, b1 = lane & 2, b0 = lane & 1;
  int q8[8], q4[4], q2[2];
#pragma unroll
  for (int k = 0; k < 8; ++k) { int snd = b2 ? pd[k] : pd[k + 8]; int kp = b2 ? pd[k + 8] : pd[k]; q8[k] = kp + __shfl_xor(snd, 4); }
#pragma unroll
  for (int k = 0; k < 4; ++k) { int snd = b1 ? q8[k] : q8[k + 4]; int kp = b1 ? q8[k + 4] : q8[k]; q4[k] = kp + __shfl_xor(snd, 2); }
#pragma unroll
  for (int k = 0; k < 2; ++k) { int snd = b0 ? q4[k] : q4[k + 2]; int kp = b0 ? q4[k + 2] : q4[k]; q2[k] = kp + __shfl_xor(snd, 1); }
  int* ap = accw + i * 128 + g * 16 + 2 * c;
  ap[0] += q2[0];
  ap[1] += q2[1];
}
DI void gv_issue(const unsigned char* __restrict__ vb, const int* idw, int i, int j, int g, int c, u32x4 (&r)[16]) {
  i32x4 id[4];
#pragma unroll
  for (int q = 0; q < 4; ++q) id[q] = *(const i32x4*)(idw + i * 128 + g * 16 + 4 * q);
  const unsigned so = (unsigned)(j * (16384 * 128) + 16 * c);
#pragma unroll
  for (int b = 0; b < 16; ++b) r[b] = *(const u32x4*)(vb + (size_t)((unsigned)id[b >> 2][b & 3] + so));
}
DI void gv_compute(const Params& p, int layer, const float* accw, int tok, int i, int j, int g, int c, int lane, const u32x4 (&r)[16], bool dry) {
  char* ws = p.ws;
  const size_t oo = (size_t)tok * 1024 + 128 * j + 16 * c + 2 * g;
  const unsigned xin = *(const unsigned*)((const short*)(ws + OFF_XB) + oo);
  f2v o = {bflo(xin), bfhi(xin)};
  f32x4 wv[4];
#pragma unroll
  for (int q = 0; q < 4; ++q) wv[q] = *(const f32x4*)(accw + i * 128 + g * 16 + 4 * q);
  f2v y[8];
#pragma unroll
  for (int q = 0; q < 8; ++q) { y[q][0] = 0.f; y[q][1] = 0.f; }
#pragma unroll
  for (int b = 0; b < 16; ++b) {
    const float wk = wv[b >> 2][b & 3];
    const f2v wk2 = {wk, wk};
#pragma unroll
    for (int q = 0; q < 4; ++q) {
      y[2 * q] += wk2 * __builtin_amdgcn_cvt_pk_f32_fp8((int)r[b][q], false);
      y[2 * q + 1] += wk2 * __builtin_amdgcn_cvt_pk_f32_fp8((int)r[b][q], true);
    }
  }
  const bool b5 = lane & 32, b4 = lane & 16, b3 = lane & 8;
  f2v y4[4], y2[2], y1;
#pragma unroll
  for (int q = 0; q < 4; ++q) {
    f2v snd = b5 ? y[q] : y[q + 4], kp = b5 ? y[q + 4] : y[q];
    y4[q][0] = kp[0] + __shfl_xor(snd[0], 32); y4[q][1] = kp[1] + __shfl_xor(snd[1], 32);
  }
#pragma unroll
  for (int q = 0; q < 2; ++q) {
    f2v snd = b4 ? y4[q] : y4[q + 2], kp = b4 ? y4[q + 2] : y4[q];
    y2[q][0] = kp[0] + __shfl_xor(snd[0], 16); y2[q][1] = kp[1] + __shfl_xor(snd[1], 16);
  }
  {
    f2v snd = b3 ? y2[0] : y2[1], kp = b3 ? y2[1] : y2[0];
    y1[0] = kp[0] + __shfl_xor(snd[0], 8); y1[1] = kp[1] + __shfl_xor(snd[1], 8);
  }
  float* ss2 = (float*)(ws + OFF_SS) + 2 * T;
  if (dry) { if (y1[0] == 123.456f) ss2[tok] = y1[1] + o[0]; return; }
  o += y1;
  if (layer == 1) *(f2v*)(p.out + oo) = o;
  if (layer == 0) {
    *(unsigned*)((short*)(ws + OFF_XB) + oo) = pack2(o[0], o[1]);
    float sq = o[0] * o[0] + o[1] * o[1];
#pragma unroll
    for (int m = 32; m > 0; m >>= 1) sq += __shfl_xor(sq, m);
    if (lane == 0) unsafeAtomicAdd(ss2 + tok, sq);
  }
}

DI void phase_gather(const Params& p, int layer, char* lds, int bid, int nb, bool dry = false) {
  char* ws = p.ws;
  const int lane = lane_id(), wid = p.wv;
  const int gw = bid * NWAVE + wid, nw = nb * NWAVE;
  float* accw = (float*)lds + wid * 2048;
  int* idw = (int*)(lds + NWAVE * 8192) + wid * 2048;
  const int* idxb = (const int*)(ws + OFF_IDX);
  const float* gsv = (const float*)(ws + OFF_G);
  const float* suv = (const float*)(ws + OFF_SUV);
  const float* ssc = (const float*)(ws + OFF_SS) + (layer == 0 ? 1 : 3) * T;
  const unsigned char* ub = (const unsigned char*)(ws + OFF_UB) + (size_t)layer * 16384 * 1024;
  const unsigned char* vb = (const unsigned char*)(ws + OFF_VB) + (size_t)layer * 16384 * 1024;
  const unsigned char* x8 = (const unsigned char*)(ws + OFF_X8);
  const int g = lane >> 3, c = lane & 7;
  for (int base = 0; base + gw < T; base += 16 * nw) {
    int ntok = (T - base - gw + nw - 1) / nw;
    ntok = ntok > 16 ? 16 : ntok;
    if (ntok == 16) {
      int t0[16], t1[16];
      const unsigned eo0 = (unsigned)(base + gw) * 128u + (unsigned)lane, st = (unsigned)nw * 128u;
#pragma unroll
      for (int i = 0; i < 16; ++i) { t0[i] = idxb[eo0 + i * st]; t1[i] = idxb[eo0 + i * st + 64u]; }
#pragma unroll
      for (int i = 0; i < 16; ++i) {
        idw[i * 128 + lane] = t0[i] << 7; idw[i * 128 + 64 + lane] = t1[i] << 7;
        accw[i * 128 + lane] = 0.f; accw[i * 128 + 64 + lane] = 0.f;
      }
    } else {
      for (int i = 0; i < ntok; ++i) {
        const size_t eo = (size_t)(base + i * nw + gw) * 128 + lane;
        idw[i * 128 + lane] = idxb[eo] << 7; idw[i * 128 + 64 + lane] = idxb[eo + 64] << 7;
        accw[i * 128 + lane] = 0.f; accw[i * 128 + 64 + lane] = 0.f;
      }
    }
    const int nit = 8 * ntok;
    u32x4 rA[16], rB[16];
    for (int rep = 0; rep < (PROBE_GU ? 2 : 1); ++rep) {
      if (rep) for (int i = 0; i < ntok; ++i) { accw[i * 128 + lane] = 0.f; accw[i * 128 + 64 + lane] = 0.f; }
      u32x4 hA, hB;
      int ji = 0, ii = 0, ic = 0;
      gu_issue(ub, x8, idw, base + ii * nw + gw, ii, ji, g, c, rA, hA); if (++ii == ntok) { ii = 0; ++ji; }
      for (int it = 0; it < nit; it += 2) {
        if (it + 1 < nit) { gu_issue(ub, x8, idw, base + ii * nw + gw, ii, ji, g, c, rB, hB); if (++ii == ntok) { ii = 0; ++ji; } }
        gu_compute((int*)accw, ic, g, c, lane, rA, hA); if (++ic == ntok) ic = 0;
        if (it + 1 < nit) {
          if (it + 2 < nit) { gu_issue(ub, x8, idw, base + ii * nw + gw, ii, ji, g, c, rA, hA); if (++ii == ntok) { ii = 0; ++ji; } }
          gu_compute((int*)accw, ic, g, c, lane, rB, hB); if (++ic == ntok) ic = 0;
        }
      }
    }
    if (ntok == 16) {
      float su0[16], su1[16], gs0[16], gs1[16];
      const unsigned eo0 = (unsigned)(base + gw) * 128u + (unsigned)lane, st = (unsigned)nw * 128u;
#pragma unroll
      for (int i = 0; i < 16; ++i) { su0[i] = suv[eo0 + i * st]; su1[i] = suv[eo0 + i * st + 64u]; gs0[i] = gsv[eo0 + i * st]; gs1[i] = gsv[eo0 + i * st + 64u]; }
#pragma unroll
      for (int i = 0; i < 16; ++i) {
        const float a0 = (float)((const int*)accw)[i * 128 + lane] * su0[i] * (6.0f / 127.0f), a1 = (float)((const int*)accw)[i * 128 + 64 + lane] * su1[i] * (6.0f / 127.0f);
        accw[i * 128 + lane] = gs0[i] * 0.5f * a0 * (1.0f + erff(a0 * 0.70710678118654752f));
        accw[i * 128 + 64 + lane] = gs1[i] * 0.5f * a1 * (1.0f + erff(a1 * 0.70710678118654752f));
      }
    } else {
      for (int i = 0; i < ntok; ++i) {
        const size_t eo = (size_t)(base + i * nw + gw) * 128 + lane;
        const float a0 = (float)((const int*)accw)[i * 128 + lane] * suv[eo] * (6.0f / 127.0f), a1 = (float)((const int*)accw)[i * 128 + 64 + lane] * suv[eo + 64] * (6.0f / 127.0f);
        accw[i * 128 + lane] = gsv[eo] * 0.5f * a0 * (1.0f + erff(a0 * 0.70710678118654752f));
        accw[i * 128 + 64 + lane] = gsv[eo + 64] * 0.5f * a1 * (1.0f + erff(a1 * 0.70710678118654752f));
      }
    }
    for (int rep = 0; rep < (PROBE_GV ? 2 : 1); ++rep) {
      const bool dryv = dry || (PROBE_GV && rep == 0);
      int ji = 0, ii = 0, jc = 0, ic = 0;
      gv_issue(vb, idw, ii, ji, g, c, rA); if (++ii == ntok) { ii = 0; ++ji; }
      for (int it = 0; it < nit; it += 2) {
        if (it + 1 < nit) { gv_issue(vb, idw, ii, ji, g, c, rB); if (++ii == ntok) { ii = 0; ++ji; } }
        gv_compute(p, layer, accw, base + ic * nw + gw, ic, jc, g, c, lane, rA, dryv); if (++ic == ntok) { ic = 0; ++jc; }
        if (it + 1 < nit) {
          if (it + 2 < nit) { gv_issue(vb, idw, ii, ji, g, c, rA); if (++ii == ntok) { ii = 0; ++ji; } }
          gv_compute(p, layer, accw, base + ic * nw + gw, ic, jc, g, c, lane, rB, dryv); if (++ic == ntok) { ic = 0; ++jc; }
        }
      }
    }
  }
}

DI void phase_convmix(const Params& p, int bid, int nb, bool dry = false) {
  char* ws = p.ws;
  short* cb = (short*)(ws + OFF_CB);
  const short* cz = (const short*)(ws + OFF_CZ);
  const float* cw = p.conv_w;
  for (size_t i = (size_t)bid * NTHR + TIDX; i < (size_t)T * 128; i += (size_t)nb * NTHR) {
    const int tok = (int)(i >> 7), ch = (int)(i & 127) * 8, pos = tok & (SEQ - 1);
    const size_t off = (size_t)tok * 1024 + ch;
    u32x4 bv = *(const u32x4*)(cb + off);
    u32x4 z0 = *(const u32x4*)(cz + off);
    u32x4 z1 = {0, 0, 0, 0}, z2 = {0, 0, 0, 0};
    if (pos >= 1) z1 = *(const u32x4*)(cz + off - 1024);
    if (pos >= 2) z2 = *(const u32x4*)(cz + off - 2048);
    u32x4 o;
#pragma unroll
    for (int j = 0; j < 4; ++j) {
      const int c0 = ch + 2 * j, c1 = c0 + 1;
      float a0 = cw[c0] * bflo(z2[j]) + cw[1024 + c0] * bflo(z1[j]) + cw[2048 + c0] * bflo(z0[j]);
      float a1 = cw[c1] * bfhi(z2[j]) + cw[1024 + c1] * bfhi(z1[j]) + cw[2048 + c1] * bfhi(z0[j]);
      o[j] = pack2(a0 * bflo(bv[j]), a1 * bfhi(bv[j]));
    }
    if (!dry) *(u32x4*)(cb + off) = o;
  }
}

constexpr int N_PHASES = 13;

DI void grid_barrier(const Params& p, unsigned* bar, unsigned gen, int bid, int nb) {
  __syncthreads();
  int ln;
  asm volatile("v_mbcnt_lo_u32_b32 %0, -1, 0\n\tv_mbcnt_hi_u32_b32 %0, -1, %0" : "=v"(ln));
  if (p.wv == 0 && ln == 0) {
    __builtin_amdgcn_fence(__ATOMIC_RELEASE, "agent");
    constexpr int NG = 32;
    const int x = bid & (NG - 1);
    const unsigned gsz = (unsigned)((nb - x + NG - 1) / NG), ngroups = (unsigned)(nb < NG ? nb : NG);
    unsigned* cnt = bar + 16 * (1 + x);
    unsigned* rel = bar + 16 * (1 + NG + x);
    const unsigned old = __hip_atomic_fetch_add(cnt, 1u, __ATOMIC_RELAXED, __HIP_MEMORY_SCOPE_AGENT);
    if (old + 1u == gen * gsz) {
      __hip_atomic_fetch_add(bar, 1u, __ATOMIC_RELAXED, __HIP_MEMORY_SCOPE_AGENT);
      while (__hip_atomic_load(bar, __ATOMIC_RELAXED, __HIP_MEMORY_SCOPE_AGENT) < gen * ngroups) __builtin_amdgcn_s_sleep(8);
      __hip_atomic_store(rel, gen, __ATOMIC_RELAXED, __HIP_MEMORY_SCOPE_AGENT);
    } else {
      while (__hip_atomic_load(rel, __ATOMIC_RELAXED, __HIP_MEMORY_SCOPE_AGENT) < gen) __builtin_amdgcn_s_sleep(16);
    }
    __builtin_amdgcn_fence(__ATOMIC_ACQUIRE, "agent");
  }
  __syncthreads();
}

__global__ void __launch_bounds__(NTHR, 2) mk(Params p_in, int ph_lo, int ph_hi) {
  Params p = p_in;
  p.wv = __builtin_amdgcn_readfirstlane((int)(threadIdx.x >> 6));
  extern __shared__ __attribute__((aligned(16))) char lds[];
  cg::grid_group grid = cg::this_grid();
  const int bid = blockIdx.x, nb = gridDim.x;
  const int vb = ((nb & 7) == 0) ? ((bid & 7) * (nb >> 3) + (bid >> 3)) : bid;
  char* ws = p.ws;
  unsigned* bar = (unsigned*)(ws + OFF_BAR);
  unsigned gen = 0;
  if (ph_lo < 0) grid.sync();
#ifndef PROBE_DUP
#define PROBE_DUP 0
#endif
#define GSYNC grid_barrier(p, bar, ++gen, bid, nb)
#define PHASE(n, call, drycall) if (ph_lo <= (n) && (n) < ph_hi) { if ((PROBE_DUP >> (n)) & 1) { drycall; GSYNC; } call; if ((n) + 1 < ph_hi) GSYNC; }
  PHASE(0, phase_prep(p, lds, bid, nb), phase_prep(p, lds, bid, nb))
  PHASE(1, gemm_phase<EPI_QKV>(p, (const short*)(ws + OFF_WQKVT), (const short*)(ws + OFF_XB), 1536, lds, vb, nb, 0), gemm_phase<EPI_QKV>(p, (const short*)(ws + OFF_WQKVT), (const short*)(ws + OFF_XB), 1536, lds, vb, nb, 0, true, PROBE_GV2))
  PHASE(2, phase_attn(p, lds, bid, nb), phase_attn(p, lds, bid, nb))
  PHASE(3, gemm_phase<EPI_RES>(p, (const short*)(ws + OFF_WOT), (const short*)(ws + OFF_O), 1024, lds, vb, nb, 0), gemm_phase<EPI_RES>(p, (const short*)(ws + OFF_WOT), (const short*)(ws + OFF_O), 1024, lds, vb, nb, 0, true, PROBE_GV2))
  PHASE(4, gemm_phase<EPI_PQ>(p, (const short*)(ws + OFF_WQT), (const short*)(ws + OFF_XB), 2048, lds, vb, nb, 0), gemm_phase<EPI_PQ>(p, (const short*)(ws + OFF_WQT), (const short*)(ws + OFF_XB), 2048, lds, vb, nb, 0, true, PROBE_GV2))
  PHASE(5, phase_score(p, 0, lds, bid, nb), phase_score(p, 0, lds, bid, nb))
  PHASE(6, phase_gather(p, 0, lds, bid, nb), phase_gather(p, 0, lds, bid, nb, true))
  PHASE(7, gemm_phase<EPI_CONVIN>(p, (const short*)(ws + OFF_WINT), (const short*)(ws + OFF_XB), 3072, lds, vb, nb, 1), gemm_phase<EPI_CONVIN>(p, (const short*)(ws + OFF_WINT), (const short*)(ws + OFF_XB), 3072, lds, vb, nb, 1, true, PROBE_GV2))
  PHASE(8, phase_convmix(p, bid, nb), phase_convmix(p, bid, nb, true))
  PHASE(9, gemm_phase<EPI_RES>(p, (const short*)(ws + OFF_WOUTT), (const short*)(ws + OFF_CB), 1024, lds, vb, nb, 1), gemm_phase<EPI_RES>(p, (const short*)(ws + OFF_WOUTT), (const short*)(ws + OFF_CB), 1024, lds, vb, nb, 1, true, PROBE_GV2))
  PHASE(10, gemm_phase<EPI_PQ>(p, (const short*)(ws + OFF_WQT) + (size_t)2048 * 1024, (const short*)(ws + OFF_XB), 2048, lds, vb, nb, 1), gemm_phase<EPI_PQ>(p, (const short*)(ws + OFF_WQT) + (size_t)2048 * 1024, (const short*)(ws + OFF_XB), 2048, lds, vb, nb, 1, true, PROBE_GV2))
  PHASE(11, phase_score(p, 1, lds, bid, nb), phase_score(p, 1, lds, bid, nb))
  PHASE(12, phase_gather(p, 1, lds, bid, nb), phase_gather(p, 1, lds, bid, nb, true))
}

extern "C" void kernel_launch(void* const* d_in, const int* in_sizes, int n_in, void* d_out, int out_size, void* d_ws, size_t ws_size,
                              hipStream_t stream) {
  static int grid_blocks = 0;
  if (!grid_blocks) {
    hipFuncSetAttribute((const void*)mk, hipFuncAttributeMaxDynamicSharedMemorySize, LDS_BYTES);
    int dev = 0, cus = 0, per_cu = 0;
    hipGetDevice(&dev);
    hipDeviceGetAttribute(&cus, hipDeviceAttributeMultiprocessorCount, dev);
    hipOccupancyMaxActiveBlocksPerMultiprocessor(&per_cu, mk, NTHR, LDS_BYTES);
    if (per_cu > 1) per_cu = 1;
    if (per_cu < 1) per_cu = 1;
    grid_blocks = cus * per_cu;
  }
  Params p{};
  p.x = (const float*)d_in[0]; p.norm_mix = (const float*)d_in[1]; p.norm_ffn = (const float*)d_in[2]; p.w_qkv = (const float*)d_in[3];
  p.q_norm = (const float*)d_in[4]; p.k_norm = (const float*)d_in[5]; p.sinks = (const float*)d_in[6]; p.w_o = (const float*)d_in[7];
  p.w_in = (const float*)d_in[8]; p.conv_w = (const float*)d_in[9]; p.w_out = (const float*)d_in[10]; p.w_query = (const float*)d_in[11];
  p.sub_keys = (const float*)d_in[12]; p.peer_u = (const float*)d_in[13]; p.peer_v = (const float*)d_in[14];
  p.out = (float*)d_out; p.ws = (char*)d_ws;
  hipMemsetAsync((char*)d_ws + OFF_BAR, 0, 8192, stream);
#if MULTI_LAUNCH
  for (int ph = 0; ph < N_PHASES; ++ph) {
    hipLaunchKernelGGL(mk, dim3(grid_blocks), dim3(NTHR), LDS_BYTES, stream, p, ph, ph + 1);
  }
#else
  int lo = 0, hi = N_PHASES;
  void* args[] = {&p, &lo, &hi};
  hipError_t e = hipLaunchCooperativeKernel((const void*)mk, dim3(grid_blocks), dim3(NTHR), args, LDS_BYTES, stream);
  if (e != hipSuccess) fprintf(stderr, "cooperative launch failed: %s (grid %d)\n", hipGetErrorString(e), grid_blocks);
#endif
}
```
